# Optimizing an MI355X kernel written in HIP

```python
import math
import jax
import jax.numpy as jnp
from jax import lax
import numpy as np

D_MODEL = 1024
BATCH = 32
SEQ = 256
DEPTH = 2
DEC_BATCH = 2
DEC_SEQ = 1024
PAST_LEN = 512

GRID_W = 64
D_FF = 2816
N_MOD = 9
NORM_EPS = 1e-6
CHUNK = 128
D_SSM = 256
SSM_HEADS = 4
SSM_HEAD_DIM = 64
SSM_STATE = 128
SSM_GROUPS = 2
SSM_CONV = 3
SSM_CONV_CH = D_SSM + 2 * SSM_GROUPS * SSM_STATE
SSM_IN = D_SSM + SSM_CONV_CH + 2 * SSM_HEADS
D_HY = 256
HY_ORDER = 2
HY_CONV = 3
HY_BANDS = 16
HY_EMB = 1 + 2 * HY_BANDS
HY_HIDDEN = 64
HY_FAST_DECAY = 0.3
HY_SLOW_DECAY = 1.5
HY_TARGET = 1e-2
HY_IN = (HY_ORDER + 1) * D_HY
HY_FILT = 2 * HY_ORDER * D_HY
D_RET = 256
RET_HEADS = 4
RET_HEAD_DIM = 64
RET_IN = 4 * D_RET
ATT_HEADS = 4
ATT_KV_HEADS = 2
HEAD_DIM = 64
D_ATT = ATT_HEADS * HEAD_DIM
ATT_IN = D_ATT + 2 * ATT_KV_HEADS * HEAD_DIM
WINDOW = 128
ATT_BLOCK = 128
ROPE_BASE = 10000.0

D_MIX = D_SSM + D_HY + D_RET + D_ATT
D_IN = SSM_IN + HY_IN + RET_IN + ATT_IN

kernel_name = 'hybrid_ssd_hyena_retention_swa_prefix_trunk'


def rmsnorm(x, w):
    xf = x.astype(jnp.float32)
    y = xf * lax.rsqrt(jnp.mean(xf * xf, axis=-1, keepdims=True) + NORM_EPS)
    return y.astype(x.dtype) * w


def modulate(x, shift, scale):
    return x * (1 + scale) + shift


def swiglu(h, w_in, w_out):
    gate, up = jnp.split(h @ w_in, 2, axis=-1)
    return (jax.nn.silu(gate) * up) @ w_out


def centred_conv(x, w, b):
    k, l = w.shape[0], x.shape[1]
    half = k // 2
    xp = jnp.pad(x, ((0, 0), (half, half), (0, 0)))
    out = xp[:, 0:l] * w[0]
    for i in range(1, k):
        out = out + xp[:, i:i + l] * w[i]
    return out + b


def chunked_scan(q, k, v, log_a, s0):
    f32 = jnp.float32
    b, l, h, n = q.shape
    p = v.shape[-1]
    nc = l // CHUNK
    qc = q.astype(f32).reshape(b, nc, CHUNK, h, n)
    kc = k.astype(f32).reshape(b, nc, CHUNK, h, n)
    vc = v.astype(f32).reshape(b, nc, CHUNK, h, p)
    cum = jnp.cumsum(log_a.astype(f32).reshape(b, nc, CHUNK, h), axis=2)
    mask = jnp.tril(jnp.ones((CHUNK, CHUNK), dtype=bool))[None, None, :, :, None]
    seg = cum[:, :, :, None, :] - cum[:, :, None, :, :]
    decay = jnp.exp(jnp.where(mask, seg, -jnp.inf))
    scores = jnp.einsum('bcihn,bcjhn->bcijh', qc, kc) * decay
    y_intra = jnp.einsum('bcijh,bcjhp->bcihp', scores, vc)
    tail = jnp.exp(cum[:, :, -1:, :] - cum)
    inc = jnp.einsum('bcjhn,bcjh,bcjhp->bchnp', kc, tail, vc)
    chunk_decay = jnp.exp(cum[:, :, -1, :])

    def step(s, inp):
        d, dinc = inp
        return d[..., None, None] * s + dinc, s

    s_final, s_prev = lax.scan(step, s0.astype(f32), (jnp.moveaxis(chunk_decay, 1, 0), jnp.moveaxis(inc, 1, 0)))
    s_prev = jnp.moveaxis(s_prev, 0, 1)
    y_inter = jnp.einsum('bcihn,bcih,bchnp->bcihp', qc, jnp.exp(cum), s_prev)
    y = (y_intra + y_inter).reshape(b, l, h, p).astype(v.dtype)
    return y, s_final


def bidir_scan(q, k_f, k_b, v, la_f, la_b, s0):
    y_f, s_f = chunked_scan(q, k_f, v, la_f, s0[:, 0])
    fl = lambda a: jnp.flip(a, axis=1)
    y_b, s_b = chunked_scan(fl(q), fl(k_b), fl(v), fl(la_b), s0[:, 1])
    return y_f + fl(y_b), jnp.stack([s_f, s_b], axis=1)


def ssd_mixer(u, conv_w, conv_b, dt_bias, a_log, d_skip, norm_w, s0):
    b, l, _ = u.shape
    z = u[..., :D_SSM]
    xbc = jax.nn.silu(centred_conv(u[..., D_SSM:D_SSM + SSM_CONV_CH], conv_w, conv_b))
    dt_raw = u[..., D_SSM + SSM_CONV_CH:].reshape(b, l, 2, SSM_HEADS)
    xs = xbc[..., :D_SSM].reshape(b, l, SSM_HEADS, SSM_HEAD_DIM)
    gs = SSM_GROUPS * SSM_STATE
    rep = SSM_HEADS // SSM_GROUPS
    bm = jnp.repeat(xbc[..., D_SSM:D_SSM + gs].reshape(b, l, SSM_GROUPS, SSM_STATE), rep, axis=2)
    cm = jnp.repeat(xbc[..., D_SSM + gs:].reshape(b, l, SSM_GROUPS, SSM_STATE), rep, axis=2)
    dt = jax.nn.softplus(dt_raw.astype(jnp.float32) + dt_bias.astype(jnp.float32))
    log_a = dt * (-jnp.exp(a_log.astype(jnp.float32)))
    k_f = bm * dt[:, :, 0, :, None]
    k_b = bm * dt[:, :, 1, :, None]
    y, s = bidir_scan(cm, k_f, k_b, xs, log_a[:, :, 0], log_a[:, :, 1], s0)
    y = (y + d_skip[:, None] * xs).reshape(b, l, D_SSM)
    return rmsnorm(y * jax.nn.silu(z), norm_w), s


def hyena_filters(l, w1, b1, w2, b2, w3, freq):
    f32 = jnp.float32
    pos = jnp.arange(l, dtype=f32)
    t = pos / (l - 1)
    bands = jnp.linspace(1e-4, HY_BANDS - 1, HY_BANDS, dtype=f32)
    ang = (2.0 * math.pi / l) * pos[:, None] * bands[None, :]
    feats = jnp.concatenate([t[:, None], jnp.cos(ang), -jnp.sin(ang)], axis=-1)
    fr = freq.astype(f32)
    h = jnp.sin(fr * (feats @ w1.astype(f32) + b1.astype(f32)))
    h = jnp.sin(fr * (h @ w2.astype(f32) + b2.astype(f32)))
    h = (h @ w3.astype(f32)).reshape(l, 2, HY_ORDER, D_HY)
    max_decay = math.log(HY_TARGET) / HY_FAST_DECAY
    min_decay = math.log(HY_TARGET) / HY_SLOW_DECAY
    deltas = jnp.abs(jnp.linspace(min_decay, max_decay, D_HY, dtype=f32))
    h = h * jnp.exp(-t[:, None] * deltas[None, :])[:, None, None, :]
    h_fwd, h_bwd = h[:, 0], h[:, 1]
    return jnp.concatenate([h_fwd, jnp.zeros((1, HY_ORDER, D_HY), f32), h_bwd[:0:-1]], axis=0)


def fft_long_conv(z, kern, d_bias):
    l = z.shape[1]
    zf = z.astype(jnp.float32)
    zk = jnp.fft.rfft(zf, n=2 * l, axis=1)
    kk = jnp.fft.rfft(kern, axis=0)
    y = jnp.fft.irfft(zk * kk[None], n=2 * l, axis=1)[:, :l]
    return (y + zf * d_bias.astype(jnp.float32)).astype(z.dtype)


def hyena_mixer(u, conv_w, conv_b, w1, b1, w2, b2, w3, freq, d_bias):
    l = u.shape[1]
    uc = centred_conv(u, conv_w, conv_b)
    v, x1, x2 = jnp.split(uc, 3, axis=-1)
    kern = hyena_filters(l, w1, b1, w2, b2, w3, freq)
    z = x1 * fft_long_conv(v, kern[:, 0], d_bias[0])
    z = x2 * fft_long_conv(z, kern[:, 1], d_bias[1])
    return z


def retention_mixer(u, decay_logit, gn_w, s0):
    b, l, _ = u.shape
    q, k, v, g = jnp.split(u, 4, axis=-1)
    hs = lambda a: a.reshape(b, l, RET_HEADS, RET_HEAD_DIM)
    q, k, v = hs(q), hs(k) * RET_HEAD_DIM ** -0.5, hs(v)
    log_g = jax.nn.log_sigmoid(decay_logit.astype(jnp.float32))
    la_f = jnp.broadcast_to(log_g[0], (b, l, RET_HEADS))
    la_b = jnp.broadcast_to(log_g[1], (b, l, RET_HEADS))
    y, s = bidir_scan(q, k, k, v, la_f, la_b, s0)
    yf = y.astype(jnp.float32)
    mu = jnp.mean(yf, axis=-1, keepdims=True)
    var = jnp.mean(jnp.square(yf - mu), axis=-1, keepdims=True)
    yn = ((yf - mu) * lax.rsqrt(var + NORM_EPS)).reshape(b, l, D_RET).astype(u.dtype) * gn_w
    return yn * jax.nn.silu(g), s


def axial_rope(x):
    l = x.shape[1]
    n_rows = l // GRID_W
    rows = jnp.repeat(jnp.arange(n_rows, dtype=jnp.float32), GRID_W)
    cols = jnp.tile(jnp.arange(GRID_W, dtype=jnp.float32), n_rows)
    nf = HEAD_DIM // 4
    inv = ROPE_BASE ** (-jnp.arange(nf, dtype=jnp.float32) / nf)

    def rot(xh, pos):
        ang = pos[:, None] * inv[None, :]
        c = jnp.cos(ang)[None, :, None, :]
        s = jnp.sin(ang)[None, :, None, :]
        x1 = xh[..., :nf].astype(jnp.float32)
        x2 = xh[..., nf:].astype(jnp.float32)
        return jnp.concatenate([x1 * c - x2 * s, x1 * s + x2 * c], axis=-1)

    half = HEAD_DIM // 2
    return jnp.concatenate([rot(x[..., :half], rows), rot(x[..., half:], cols)], axis=-1).astype(x.dtype)


def context_attention(q, k, v, sink):
    b, l = q.shape[:2]
    g = ATT_HEADS // ATT_KV_HEADS
    nb = l // ATT_BLOCK
    qb = q.reshape(b, nb, ATT_BLOCK, ATT_KV_HEADS, g, HEAD_DIM)
    sink_l = sink.astype(jnp.float32).reshape(ATT_KV_HEADS, g)[None, :, :, None, None]
    scale = HEAD_DIM ** -0.5

    def block(i):
        qi = lax.dynamic_index_in_dim(qb, i, axis=1, keepdims=False)
        s = jnp.einsum('bqkgd,bskd->bkgqs', qi, k).astype(jnp.float32) * scale
        s = jnp.concatenate([jnp.broadcast_to(sink_l, s.shape[:-1] + (1,)), s], axis=-1)
        p = jax.nn.softmax(s, axis=-1)[..., 1:].astype(v.dtype)
        return jnp.einsum('bkgqs,bskd->bqkgd', p, v)

    o = lax.map(block, jnp.arange(nb))
    return jnp.moveaxis(o, 0, 1).reshape(b, l, D_ATT)


def latent_attention(q, k, v, ck, cv, sink):
    b, l = q.shape[:2]
    lc = ck.shape[1]
    g = ATT_HEADS // ATT_KV_HEADS
    nb = l // ATT_BLOCK
    qb = q.reshape(b, nb, ATT_BLOCK, ATT_KV_HEADS, g, HEAD_DIM)
    pad = ((0, 0), (ATT_BLOCK, ATT_BLOCK), (0, 0), (0, 0))
    kp, vp = jnp.pad(k, pad), jnp.pad(v, pad)
    sink_l = sink.astype(jnp.float32).reshape(ATT_KV_HEADS, g)[None, :, :, None, None]
    scale = HEAD_DIM ** -0.5
    q_off = jnp.arange(ATT_BLOCK)
    k_off = jnp.arange(3 * ATT_BLOCK)

    def block(i):
        qi = lax.dynamic_index_in_dim(qb, i, axis=1, keepdims=False)
        ki = lax.dynamic_slice_in_dim(kp, i * ATT_BLOCK, 3 * ATT_BLOCK, axis=1)
        vi = lax.dynamic_slice_in_dim(vp, i * ATT_BLOCK, 3 * ATT_BLOCK, axis=1)
        qpos = i * ATT_BLOCK + q_off
        kpos = (i - 1) * ATT_BLOCK + k_off
        valid = (jnp.abs(qpos[:, None] - kpos[None, :]) <= WINDOW) & ((kpos >= 0) & (kpos < l))[None, :]
        s_loc = jnp.einsum('bqkgd,bskd->bkgqs', qi, ki).astype(jnp.float32) * scale
        s_loc = jnp.where(valid, s_loc, -jnp.inf)
        s_ctx = jnp.einsum('bqkgd,bskd->bkgqs', qi, ck).astype(jnp.float32) * scale
        s = jnp.concatenate([jnp.broadcast_to(sink_l, s_loc.shape[:-1] + (1,)), s_ctx, s_loc], axis=-1)
        p = jax.nn.softmax(s, axis=-1).astype(v.dtype)
        return (jnp.einsum('bkgqs,bskd->bqkgd', p[..., 1:1 + lc], cv)
                + jnp.einsum('bkgqs,bskd->bqkgd', p[..., 1 + lc:], vi))

    o = lax.map(block, jnp.arange(nb))
    return jnp.moveaxis(o, 0, 1).reshape(b, l, D_ATT)


def token_mixing(h, lp, ssd_s0, ret_s0, ctx_kv):
    u = h @ lp['mix_w_in']
    o1 = SSM_IN
    o2 = o1 + HY_IN
    o3 = o2 + RET_IN
    y_ssd, s_ssd = ssd_mixer(u[..., :o1], lp['ssd_conv_w'], lp['ssd_conv_b'], lp['ssd_dt_bias'],
                             lp['ssd_a_log'], lp['ssd_d'], lp['ssd_norm_w'], ssd_s0)
    y_hy = hyena_mixer(u[..., o1:o2], lp['hy_conv_w'], lp['hy_conv_b'], lp['hy_w1'], lp['hy_b1'],
                       lp['hy_w2'], lp['hy_b2'], lp['hy_w3'], lp['hy_freq'], lp['hy_bias'])
    y_ret, s_ret = retention_mixer(u[..., o2:o3], lp['ret_decay_logit'], lp['ret_gn_w'], ret_s0)
    ua = u[..., o3:]
    b, l = ua.shape[:2]
    kvw = ATT_KV_HEADS * HEAD_DIM
    q = rmsnorm(ua[..., :D_ATT].reshape(b, l, ATT_HEADS, HEAD_DIM), lp['attn_q_norm'])
    k = rmsnorm(ua[..., D_ATT:D_ATT + kvw].reshape(b, l, ATT_KV_HEADS, HEAD_DIM), lp['attn_k_norm'])
    v = ua[..., D_ATT + kvw:].reshape(b, l, ATT_KV_HEADS, HEAD_DIM)
    if ctx_kv is None:
        y_att = context_attention(q, k, v, lp['attn_sink'])
    else:
        y_att = latent_attention(axial_rope(q), axial_rope(k), v, ctx_kv[0], ctx_kv[1], lp['attn_sink'])
    y = jnp.concatenate([y_ssd, y_hy, y_ret, y_att], axis=-1) @ lp['mix_w_out']
    return y, s_ssd, s_ret, k, v


def trunk_layer(x, cond, lp, ssd_s0, ret_s0, ctx_kv):
    mod = (jax.nn.silu(cond) @ lp['w_mod'] + lp['b_mod'])[:, None, :]
    sh1, sc1, g1, sh2, sc2, g2, sh3, sc3, g3 = jnp.split(mod, N_MOD, axis=-1)
    nw = lp['norm_w']
    x = x + 0.5 * g1 * swiglu(modulate(rmsnorm(x, nw[0]), sh1, sc1), lp['ffn_w_in'][0], lp['ffn_w_out'][0])
    y, s_ssd, s_ret, k, v = token_mixing(modulate(rmsnorm(x, nw[1]), sh2, sc2), lp, ssd_s0, ret_s0, ctx_kv)
    x = x + g2 * y
    x = x + 0.5 * g3 * swiglu(modulate(rmsnorm(x, nw[2]), sh3, sc3), lp['ffn_w_in'][1], lp['ffn_w_out'][1])
    return x, s_ssd, s_ret, k, v


def setup_inputs(seed: int = 0) -> dict:
    key = jax.random.key(seed)
    ks = iter(jax.random.split(key, 48))
    f32 = jnp.float32

    def nrm(shape, s):
        return jax.random.normal(next(ks), shape, f32) * s

    x_prompt = nrm((BATCH, SEQ, D_MODEL), 1.0)
    x_sample = nrm((DEC_BATCH, DEC_SEQ, D_MODEL), 1.0)
    cache_k = nrm((DEC_BATCH, DEPTH, PAST_LEN, ATT_KV_HEADS, HEAD_DIM), 1.0)
    cache_v = nrm((DEC_BATCH, DEPTH, PAST_LEN, ATT_KV_HEADS, HEAD_DIM), 1.0)
    state_ssd = nrm((DEC_BATCH, DEPTH, 2, SSM_HEADS, SSM_STATE, SSM_HEAD_DIM), 0.1)
    state_ret = nrm((DEC_BATCH, DEPTH, 2, RET_HEADS, RET_HEAD_DIM, RET_HEAD_DIM), 1.0)
    c = nrm((DEC_BATCH, D_MODEL), 1.0)
    c_ctx = nrm((D_MODEL,), 1.0)
    w_mod = nrm((DEPTH, D_MODEL, N_MOD * D_MODEL), 0.5 * D_MODEL ** -0.5)
    b_mod = nrm((DEPTH, N_MOD * D_MODEL), 0.02)
    norm_w = 1.0 + nrm((DEPTH, 3, D_MODEL), 0.02)
    ffn_w_in = nrm((DEPTH, 2, D_MODEL, 2 * D_FF), D_MODEL ** -0.5)
    ffn_w_out = nrm((DEPTH, 2, D_FF, D_MODEL), D_FF ** -0.5)
    mix_w_in = nrm((DEPTH, D_MODEL, D_IN), D_MODEL ** -0.5)
    mix_w_out = nrm((DEPTH, D_MIX, D_MODEL), D_MIX ** -0.5)
    ssd_conv_w = nrm((DEPTH, SSM_CONV, SSM_CONV_CH), SSM_CONV ** -0.5)
    ssd_conv_b = nrm((DEPTH, SSM_CONV_CH), 0.02)
    dt0 = jnp.exp(jax.random.uniform(next(ks), (DEPTH, 2, SSM_HEADS), f32, math.log(1e-3), math.log(1e-1)))
    ssd_dt_bias = dt0 + jnp.log(-jnp.expm1(-dt0))
    ssd_a_log = jnp.log(jax.random.uniform(next(ks), (DEPTH, 2, SSM_HEADS), f32, 1.0, 16.0))
    ssd_d = 1.0 + nrm((DEPTH, SSM_HEADS), 0.1)
    ssd_norm_w = 1.0 + nrm((DEPTH, D_SSM), 0.02)
    hy_conv_w = nrm((DEPTH, HY_CONV, HY_IN), HY_CONV ** -0.5)
    hy_conv_b = nrm((DEPTH, HY_IN), 0.02)
    hy_w1 = nrm((DEPTH, HY_EMB, HY_HIDDEN), HY_EMB ** -0.5)
    hy_b1 = nrm((DEPTH, HY_HIDDEN), 0.1)
    hy_w2 = nrm((DEPTH, HY_HIDDEN, HY_HIDDEN), HY_HIDDEN ** -0.5)
    hy_b2 = nrm((DEPTH, HY_HIDDEN), 0.1)
    hy_w3 = nrm((DEPTH, HY_HIDDEN, HY_FILT), 0.05 * HY_HIDDEN ** -0.5)
    hy_freq = 1.0 + nrm((DEPTH, HY_HIDDEN), 0.1)
    hy_bias = 1.0 + nrm((DEPTH, HY_ORDER, D_HY), 0.1)
    gamma0 = 1.0 - 2.0 ** (-5.0 - jnp.arange(RET_HEADS, dtype=f32))
    ret_decay_logit = jnp.log(gamma0 / (1.0 - gamma0)) + nrm((DEPTH, 2, RET_HEADS), 0.05)
    ret_gn_w = 1.0 + nrm((DEPTH, D_RET), 0.02)
    attn_q_norm = 1.0 + nrm((DEPTH, HEAD_DIM), 0.02)
    attn_k_norm = 1.0 + nrm((DEPTH, HEAD_DIM), 0.02)
    attn_sink = nrm((DEPTH, ATT_HEADS), 0.5)
    return {'x_prompt': x_prompt, 'x_sample': x_sample, 'cache_k': cache_k, 'cache_v': cache_v,
            'state_ssd': state_ssd, 'state_ret': state_ret, 'c': c, 'c_ctx': c_ctx,
            'w_mod': w_mod, 'b_mod': b_mod, 'norm_w': norm_w, 'ffn_w_in': ffn_w_in, 'ffn_w_out': ffn_w_out,
            'mix_w_in': mix_w_in, 'mix_w_out': mix_w_out, 'ssd_conv_w': ssd_conv_w, 'ssd_conv_b': ssd_conv_b,
            'ssd_dt_bias': ssd_dt_bias, 'ssd_a_log': ssd_a_log, 'ssd_d': ssd_d, 'ssd_norm_w': ssd_norm_w,
            'hy_conv_w': hy_conv_w, 'hy_conv_b': hy_conv_b, 'hy_w1': hy_w1, 'hy_b1': hy_b1, 'hy_w2': hy_w2,
            'hy_b2': hy_b2, 'hy_w3': hy_w3, 'hy_freq': hy_freq, 'hy_bias': hy_bias,
            'ret_decay_logit': ret_decay_logit, 'ret_gn_w': ret_gn_w, 'attn_q_norm': attn_q_norm,
            'attn_k_norm': attn_k_norm, 'attn_sink': attn_sink}


def reference(x_prompt, x_sample, cache_k, cache_v, state_ssd, state_ret, c, c_ctx,
              w_mod, b_mod, norm_w, ffn_w_in, ffn_w_out, mix_w_in, mix_w_out,
              ssd_conv_w, ssd_conv_b, ssd_dt_bias, ssd_a_log, ssd_d, ssd_norm_w,
              hy_conv_w, hy_conv_b, hy_w1, hy_b1, hy_w2, hy_b2, hy_w3, hy_freq, hy_bias,
              ret_decay_logit, ret_gn_w, attn_q_norm, attn_k_norm, attn_sink):
    bp = x_prompt.shape[0]
    yp, ys = x_prompt, x_sample
    new_k, new_v, new_ssd, new_ret = [], [], [], []
    for li in range(DEPTH):
        lp = dict(w_mod=w_mod[li], b_mod=b_mod[li], norm_w=norm_w[li], ffn_w_in=ffn_w_in[li],
                  ffn_w_out=ffn_w_out[li], mix_w_in=mix_w_in[li], mix_w_out=mix_w_out[li],
                  ssd_conv_w=ssd_conv_w[li], ssd_conv_b=ssd_conv_b[li], ssd_dt_bias=ssd_dt_bias[li],
                  ssd_a_log=ssd_a_log[li], ssd_d=ssd_d[li], ssd_norm_w=ssd_norm_w[li],
                  hy_conv_w=hy_conv_w[li], hy_conv_b=hy_conv_b[li], hy_w1=hy_w1[li], hy_b1=hy_b1[li],
                  hy_w2=hy_w2[li], hy_b2=hy_b2[li], hy_w3=hy_w3[li], hy_freq=hy_freq[li], hy_bias=hy_bias[li],
                  ret_decay_logit=ret_decay_logit[li], ret_gn_w=ret_gn_w[li], attn_q_norm=attn_q_norm[li],
                  attn_k_norm=attn_k_norm[li], attn_sink=attn_sink[li])
        zs_ssd = jnp.zeros((bp, 2, SSM_HEADS, SSM_STATE, SSM_HEAD_DIM), jnp.float32)
        zs_ret = jnp.zeros((bp, 2, RET_HEADS, RET_HEAD_DIM, RET_HEAD_DIM), jnp.float32)
        yp, s_ssd, s_ret, k_ctx, v_ctx = trunk_layer(yp, c_ctx[None, :], lp, zs_ssd, zs_ret, None)
        new_k.append(k_ctx)
        new_v.append(v_ctx)
        new_ssd.append(s_ssd)
        new_ret.append(s_ret)
        ys = trunk_layer(ys, c, lp, state_ssd[:, li], state_ret[:, li], (cache_k[:, li], cache_v[:, li]))[0]
    new_cache_k = jnp.stack(new_k, axis=1)
    new_cache_v = jnp.stack(new_v, axis=1)
    new_state_ssd = jnp.stack(new_ssd, axis=1)
    new_state_ret = jnp.stack(new_ret, axis=1)
    return (yp, ys, new_cache_k, new_cache_v, new_state_ssd, new_state_ret)
```

```cpp
#include <hip/hip_runtime.h>
#include <hip/hip_cooperative_groups.h>
#include <cstdio>
#include <cstdint>
namespace cg = cooperative_groups;

#ifndef MK_EN
#define MK_EN 0xFFFF
#endif
#define EN(b) ((MK_EN >> (b)) & 1)
#ifndef MK_KEEP
#define MK_KEEP 0x3F
#endif
#ifndef MK_MULTI
#define MK_MULTI 0
#endif

#define GAS __attribute__((address_space(1)))
#define LAS __attribute__((address_space(3)))
typedef unsigned short bf16;
typedef float f32x4 __attribute__((ext_vector_type(4)));
typedef float f32x2 __attribute__((ext_vector_type(2)));
typedef unsigned u32x4 __attribute__((ext_vector_type(4)));
typedef unsigned u32x2 __attribute__((ext_vector_type(2)));
typedef unsigned short u16x4 __attribute__((ext_vector_type(4)));

namespace pg8 {
#define PG8_LAS __attribute__((address_space(3)))
typedef unsigned short bf16_t;
typedef short bf16x8 __attribute__((ext_vector_type(8)));
constexpr int BM = 256, BK = 64, HALF = 128, HTB = HALF * BK * 2, STAGE_BYTES = 8 * HTB, NXCD = 8, WGM = 8;

__host__ __device__ __forceinline__ int lds_byte(int r, int c) { const int st = (r >> 4) * 2 + (c >> 5), rr = r & 15, cc = c & 31, ob = rr * 64 + cc * 2; return st * 1024 + (ob ^ (((ob >> 9) & 1) << 5)); }
__host__ __device__ __forceinline__ void stage_rc(int b, int& R, int& C) { const int st = b / 1024, sb = b % 1024, swz = sb ^ (((sb >> 9) & 1) << 5); R = (st >> 1) * 16 + swz / 64; C = (st & 1) * 32 + (swz % 64) / 2; }
__host__ __device__ __forceinline__ int perm32(int rho) { const int n = rho >> 4, i = rho & 15; return 8 * (i >> 2) + 4 * n + (i & 3); }

struct Unit { int pm, pn; };
struct Gemm { const bf16_t* A; const bf16_t* Bt; int M, N, K; };

struct StaticOrder {
    int nM, nN, nwg, G, c;
    __host__ __device__ void init(int M, int N, int G_, int c_) { nM = M / BM; nN = N / BM; nwg = nM * nN; G = G_; c = c_; }
    __host__ __device__ bool next(int i, Unit& u) const {
        const long L = (long)i * G + c; if (L >= nwg) return false;
        int wgid = (int)L; { const int q = nwg / NXCD, r = nwg % NXCD, xcd = wgid % NXCD, off = wgid / NXCD; wgid = (xcd < r ? xcd * (q + 1) : r * (q + 1) + (xcd - r) * q) + off; }
        const int nig = WGM * nN, gid = wgid / nig, fm = gid * WGM, gsz = (nM - fm) < WGM ? (nM - fm) : WGM;
        u.pm = fm + ((wgid % nig) % gsz); u.pn = (wgid % nig) / gsz; return true;
    }
    __device__ __forceinline__ void a_ready(const Unit&) const {}
    __device__ __forceinline__ void done(const Unit&) const {}
};

__device__ __forceinline__ unsigned cvt_pk_bf16(float lo, float hi) { unsigned r; asm volatile("v_cvt_pk_bf16_f32 %0, %1, %2" : "=v"(r) : "v"(lo), "v"(hi)); return r; }
__device__ __forceinline__ float silu_f(float v) { return v * __builtin_amdgcn_rcpf(1.0f + __expf(-v)); }

struct EpiSwiglu {
    static constexpr bool PERM = true, AFTER_DRAIN = false;
    bf16_t* O; int ldc;
    __device__ __forceinline__ void operator()(const f32x4 (&acc)[2][2][4][2], const Unit& u, int wr, int wc, int fr, int fq) const {
        const int row0 = u.pm * BM + wr * 64 + fr, col0 = u.pn * HALF + wc * 32 + 8 * fq;
#pragma unroll
        for (int ai = 0; ai < 2; ++ai)
#pragma unroll
            for (int m = 0; m < 4; ++m) { bf16_t* rowp = O + (size_t)(row0 + ai * HALF + m * 16) * ldc + col0;
                const f32x4 g0 = acc[ai][0][m][0], g1 = acc[ai][0][m][1], u0 = acc[ai][1][m][0], u1 = acc[ai][1][m][1];
                u32x4 w;
                w.x = cvt_pk_bf16(silu_f(g0[0]) * u0[0], silu_f(g0[1]) * u0[1]); w.y = cvt_pk_bf16(silu_f(g0[2]) * u0[2], silu_f(g0[3]) * u0[3]);
                w.z = cvt_pk_bf16(silu_f(g1[0]) * u1[0], silu_f(g1[1]) * u1[1]); w.w = cvt_pk_bf16(silu_f(g1[2]) * u1[2], silu_f(g1[3]) * u1[3]);
                *(u32x4*)rowp = w; }
    }
};
struct EpiBf16 {
    static constexpr bool PERM = true, AFTER_DRAIN = false;
    bf16_t* O; int ldc;
    __device__ __forceinline__ void operator()(const f32x4 (&acc)[2][2][4][2], const Unit& u, int wr, int wc, int fr, int fq) const {
        const int row0 = u.pm * BM + wr * 64 + fr, col0 = u.pn * BM + wc * 32 + 8 * fq;
#pragma unroll
        for (int ai = 0; ai < 2; ++ai)
#pragma unroll
            for (int m = 0; m < 4; ++m) { bf16_t* rowp = O + (size_t)(row0 + ai * HALF + m * 16) * ldc + col0;
#pragma unroll
                for (int bj = 0; bj < 2; ++bj) { const f32x4 v0 = acc[ai][bj][m][0], v1 = acc[ai][bj][m][1];
                    u32x4 w; w.x = cvt_pk_bf16(v0[0], v0[1]); w.y = cvt_pk_bf16(v0[2], v0[3]); w.z = cvt_pk_bf16(v1[0], v1[1]); w.w = cvt_pk_bf16(v1[2], v1[3]);
                    *(u32x4*)(rowp + bj * HALF) = w; } }
    }
};
struct EpiResid {
    static constexpr bool PERM = false, AFTER_DRAIN = false;
    const float* xin_ctx; const float* xin_lat; float* out; const float* gate; float scale;
    __device__ __forceinline__ void operator()(const f32x4 (&acc)[2][2][4][2], const Unit& u, int wr, int wc, int fr, int fq) const {
        const int row0 = u.pm * BM + wr * 64 + fr, col0 = u.pn * BM + wc * 32 + 4 * fq;
        const int cidx = u.pm < 32 ? 0 : 1 + ((u.pm - 32) >> 2);
        const float* xin = u.pm < 32 ? xin_ctx : xin_lat;
        const float* gp = gate + cidx * 9216 + col0;
        f32x4 gv[2][2];
#pragma unroll
        for (int bj = 0; bj < 2; ++bj)
#pragma unroll
            for (int n = 0; n < 2; ++n) gv[bj][n] = *(const f32x4*)(gp + bj * HALF + n * 16) * scale;
#pragma unroll
        for (int ai = 0; ai < 2; ++ai)
#pragma unroll
            for (int m = 0; m < 4; ++m) { const size_t off = (size_t)(row0 + ai * HALF + m * 16) * 1024 + col0;
#pragma unroll
                for (int bj = 0; bj < 2; ++bj)
#pragma unroll
                    for (int n = 0; n < 2; ++n) { const f32x4 xv = *(const f32x4*)(xin + off + bj * HALF + n * 16);
                        *(f32x4*)(out + off + bj * HALF + n * 16) = xv + gv[bj][n] * acc[ai][bj][m][n]; } }
    }
};

template <class Epi, class Sched, bool ALIGN_EPI = false, bool SP2 = false>
__device__ __forceinline__ void gemm_phase(PG8_LAS unsigned char* lds, const Gemm g, const Sched& S, const Epi& E, const int tid) {
    const int wid = __builtin_amdgcn_readfirstlane(tid >> 6), lane = tid & 63, wr = wid >> 2, wc = wid & 3, fr = lane & 15, fq = lane >> 4;
    const int K = g.K, nt = K / BK;
    unsigned voffA[2], voffB[2];
#pragma unroll
    for (int i = 0; i < 2; ++i) { int R, C; stage_rc(tid * 16 + i * 8192, R, C); const int Rb = Epi::PERM ? ((R & ~31) + perm32(R & 31)) : R;
        voffA[i] = (unsigned)(R * K + C) * 2u; voffB[i] = (unsigned)(Rb * K + C) * 2u; }
    const size_t kstep = (size_t)(BK * 2);
    const size_t hstep = (size_t)HALF * K * 2;
    const size_t tstep = 2 * hstep;
    const unsigned ldsw = (unsigned)wid * 1024u;
    const int aoff = lds_byte(wr * 64 + fr, fq * 8), boff = lds_byte(wc * 32 + fr, fq * 8);
#define PG8_SA(b, h) (((b) * 2 + (h)) * HTB)
#define PG8_SB(b, h) ((4 + (b) * 2 + (h)) * HTB)
#define PG8_STAGE(bufoff, gbase, voff) do { _Pragma("unroll") for (int _i = 0; _i < 2; ++_i) \
        __builtin_amdgcn_global_load_lds((const unsigned*)((const char*)(gbase) + (voff)[_i]), (PG8_LAS unsigned*)(lds + (bufoff) + ldsw + _i * 8192), 16, 0, 0); } while (0)
#define PG8_LDA(dst, b, h) do { _Pragma("unroll") for (int m = 0; m < 4; ++m) _Pragma("unroll") for (int k = 0; k < 2; ++k) dst[m][k] = *(const PG8_LAS bf16x8*)(lds + PG8_SA(b, h) + aoff + m * 2048 + k * 1024); } while (0)
#define PG8_LDB(dst, b, h) do { _Pragma("unroll") for (int n = 0; n < 2; ++n) _Pragma("unroll") for (int k = 0; k < 2; ++k) dst[n][k] = *(const PG8_LAS bf16x8*)(lds + PG8_SB(b, h) + boff + n * 2048 + k * 1024); } while (0)
#define PG8_MMA(ai, bj, At, Bt) do { __builtin_amdgcn_s_setprio(1); _Pragma("unroll") for (int m = 0; m < 4; ++m) _Pragma("unroll") for (int n = 0; n < 2; ++n) _Pragma("unroll") for (int k = 0; k < 2; ++k) \
        acc[ai][bj][m][n] = __builtin_amdgcn_mfma_f32_16x16x32_bf16(Bt[n][k], At[m][k], acc[ai][bj][m][n], 0, 0, 0); __builtin_amdgcn_s_setprio(0); } while (0)
#define PG8_WAIT_V(n) asm volatile("s_waitcnt vmcnt(" #n ")" ::: "memory")
#define PG8_WAIT_L(n) asm volatile("s_waitcnt lgkmcnt(" #n ")" ::: "memory")
#define PG8_BAR __builtin_amdgcn_s_barrier()
#define PG8_SCHED __builtin_amdgcn_sched_barrier(0)
    Unit cur, nxt; int ui = 0;
    if (!S.next(0, cur)) return;
    f32x4 acc[2][2][4][2];
#pragma unroll
    for (int a = 0; a < 2; ++a)
#pragma unroll
        for (int b = 0; b < 2; ++b)
#pragma unroll
            for (int m = 0; m < 4; ++m)
#pragma unroll
                for (int n = 0; n < 2; ++n) acc[a][b][m][n] = (f32x4){0.f, 0.f, 0.f, 0.f};
    bf16x8 At[4][2], B0[2][2], B1[2][2];
    const char* cA = (const char*)g.A + (size_t)cur.pm * tstep; const char* cB = (const char*)g.Bt + (size_t)cur.pn * tstep;
    S.a_ready(cur);
    if constexpr (SP2) {
        PG8_STAGE(PG8_SB(0, 0), cB, voffB); PG8_STAGE(PG8_SB(0, 1), cB + hstep, voffB); PG8_STAGE(PG8_SA(0, 0), cA, voffA); PG8_STAGE(PG8_SA(0, 1), cA + hstep, voffA);
        if (wr == 1) PG8_BAR;
        PG8_WAIT_V(2); PG8_BAR;
        PG8_STAGE(PG8_SB(1, 0), cB + kstep, voffB); PG8_STAGE(PG8_SA(1, 0), cA + kstep, voffA); PG8_STAGE(PG8_SB(1, 1), cB + hstep + kstep, voffB);
        PG8_WAIT_V(6); PG8_BAR;
    } else {
        PG8_STAGE(PG8_SB(0, 0), cB, voffB); PG8_STAGE(PG8_SA(0, 0), cA, voffA); PG8_STAGE(PG8_SB(0, 1), cB + hstep, voffB); PG8_STAGE(PG8_SA(0, 1), cA + hstep, voffA);
        if (wr == 1) PG8_BAR;
        PG8_WAIT_V(4); PG8_BAR;
        PG8_STAGE(PG8_SB(1, 0), cB + kstep, voffB); PG8_STAGE(PG8_SA(1, 0), cA + kstep, voffA); PG8_STAGE(PG8_SB(1, 1), cB + hstep + kstep, voffB);
        PG8_WAIT_V(6); PG8_BAR;
    }
    for (;;) {
        const bool has_next = S.next(ui + 1, nxt);
        const char* nA = has_next ? (const char*)g.A + (size_t)nxt.pm * tstep : cA; const char* nB = has_next ? (const char*)g.Bt + (size_t)nxt.pn * tstep : cB;
        for (int t = 0; t < nt; t += 2) {
            const bool last = (t == nt - 2);
            const char* a1 = cA + (size_t)(t + 1) * kstep;
            const char* a2 = last ? nA : cA + (size_t)(t + 2) * kstep; const char* b2 = last ? nB : cB + (size_t)(t + 2) * kstep;
            const char* a3 = a2 + kstep; const char* b3 = b2 + kstep;
            if (last && has_next) S.a_ready(nxt);
            if constexpr (SP2) {
            PG8_LDB(B0, 0, 0); PG8_LDB(B1, 0, 1); PG8_SCHED; PG8_LDA(At, 0, 0); PG8_STAGE(PG8_SA(1, 1), a1 + hstep, voffA);
            PG8_WAIT_V(8); PG8_WAIT_L(0); PG8_BAR; PG8_MMA(0, 0, At, B0); PG8_MMA(0, 1, At, B1); PG8_BAR; PG8_SCHED;
            PG8_LDA(At, 0, 1); PG8_STAGE(PG8_SB(0, 0), b2, voffB); PG8_STAGE(PG8_SB(0, 1), b2 + hstep, voffB); PG8_STAGE(PG8_SA(0, 0), a2, voffA);
            PG8_WAIT_V(8); PG8_WAIT_L(0); PG8_BAR; PG8_MMA(1, 0, At, B0); PG8_MMA(1, 1, At, B1); PG8_BAR; PG8_SCHED;
            PG8_LDB(B0, 1, 0); PG8_LDB(B1, 1, 1); PG8_SCHED; PG8_LDA(At, 1, 0); PG8_STAGE(PG8_SA(0, 1), a2 + hstep, voffA);
            PG8_WAIT_V(8); PG8_WAIT_L(0); PG8_BAR; PG8_MMA(0, 0, At, B0); PG8_MMA(0, 1, At, B1); PG8_BAR; PG8_SCHED;
            PG8_LDA(At, 1, 1); PG8_STAGE(PG8_SB(1, 0), b3, voffB); PG8_STAGE(PG8_SB(1, 1), b3 + hstep, voffB); PG8_STAGE(PG8_SA(1, 0), a3, voffA);
            PG8_WAIT_V(8); PG8_WAIT_L(0); PG8_BAR; PG8_MMA(1, 0, At, B0); PG8_MMA(1, 1, At, B1); PG8_BAR; PG8_SCHED;
            } else {
            PG8_LDB(B0, 0, 0); PG8_SCHED; PG8_LDA(At, 0, 0); PG8_STAGE(PG8_SA(1, 1), a1 + hstep, voffA);
            PG8_WAIT_L(8); PG8_BAR; PG8_WAIT_L(0); PG8_MMA(0, 0, At, B0); PG8_BAR; PG8_SCHED;
            PG8_LDB(B1, 0, 1); PG8_STAGE(PG8_SB(0, 0), b2, voffB);
            PG8_BAR; PG8_WAIT_L(0); PG8_MMA(0, 1, At, B1); PG8_BAR;
            PG8_LDA(At, 0, 1); PG8_STAGE(PG8_SA(0, 0), a2, voffA);
            PG8_BAR; PG8_WAIT_L(0); PG8_MMA(1, 0, At, B0); PG8_BAR; PG8_SCHED;
            PG8_STAGE(PG8_SB(0, 1), b2 + hstep, voffB);
            PG8_WAIT_V(6); PG8_BAR; PG8_MMA(1, 1, At, B1); PG8_BAR;
            PG8_LDB(B0, 1, 0); PG8_SCHED; PG8_LDA(At, 1, 0); PG8_STAGE(PG8_SA(0, 1), a2 + hstep, voffA);
            PG8_WAIT_L(8); PG8_BAR; PG8_WAIT_L(0); PG8_MMA(0, 0, At, B0); PG8_BAR; PG8_SCHED;
            PG8_LDB(B1, 1, 1); PG8_STAGE(PG8_SB(1, 0), b3, voffB);
            PG8_BAR; PG8_WAIT_L(0); PG8_MMA(0, 1, At, B1); PG8_BAR;
            PG8_LDA(At, 1, 1); PG8_STAGE(PG8_SA(1, 0), a3, voffA);
            PG8_BAR; PG8_WAIT_L(0); PG8_MMA(1, 0, At, B0); PG8_BAR; PG8_SCHED;
            PG8_STAGE(PG8_SB(1, 1), b3 + hstep, voffB);
            PG8_WAIT_V(6); PG8_BAR; PG8_MMA(1, 1, At, B1); PG8_BAR;
            }
        }
        if constexpr (ALIGN_EPI) { if (wr == 0) PG8_BAR; }
        if constexpr (!Epi::AFTER_DRAIN) { E(acc, cur, wr, wc, fr, fq); S.done(cur); }
        if (!has_next) break;
#pragma unroll
        for (int a = 0; a < 2; ++a)
#pragma unroll
            for (int b = 0; b < 2; ++b)
#pragma unroll
                for (int m = 0; m < 4; ++m)
#pragma unroll
                    for (int n = 0; n < 2; ++n) acc[a][b][m][n] = (f32x4){0.f, 0.f, 0.f, 0.f};
        cur = nxt; cA = nA; cB = nB; ++ui;
        if constexpr (ALIGN_EPI) { if (wr == 1) PG8_BAR; }
    }
    PG8_WAIT_V(0);
    if constexpr (!ALIGN_EPI) { if (wr == 0) PG8_BAR; }
    PG8_BAR;
#undef PG8_SA
#undef PG8_SB
#undef PG8_STAGE
#undef PG8_LDA
#undef PG8_LDB
#undef PG8_MMA
#undef PG8_WAIT_V
#undef PG8_WAIT_L
#undef PG8_BAR
#undef PG8_SCHED
}
}

constexpr int NTHR = 512, NWAVES = 8;
constexpr int D = 1024, TCTX = 8192, TLAT = 2048, TT = 10240, DFF = 2816;
constexpr int DIN = 3336, DINP = 3584;
constexpr int U_Z = 0, U_XBC = 256, U_DT = 1024, U_HY = 1032, U_RET = 1800, U_ATT = 2824;
constexpr float EPS = 1e-6f;
constexpr int NPHASE = 25;

constexpr size_t MiB = 1u << 20;
constexpr size_t WS_CTL = 0, CTL_ZERO_BYTES = 65536;
constexpr size_t WS_MOD = 1 * MiB;
constexpr size_t WS_HK = 2 * MiB, HK_LAYER = 6 * MiB, HK1024_OFF = 1310720;
constexpr size_t WS_W = 14 * MiB, W_LAYER = 42 * MiB;
constexpr size_t W_IN0 = 0, W_IN1 = 11 * MiB, W_OUT0 = 22 * MiB, W_OUT1 = 22 * MiB + 5767168, W_MI = 33 * MiB, W_MO = 40 * MiB;
constexpr size_t WS_H = 98 * MiB;
constexpr size_t WS_YMIX = 118 * MiB;
constexpr size_t WS_UA = 138 * MiB;
constexpr size_t WS_XBC = 208 * MiB;
constexpr size_t WS_QK = 238 * MiB;
constexpr size_t WS_YS = 253 * MiB;
constexpr size_t WS_YR = 273 * MiB;
constexpr size_t WS_Z1 = 293 * MiB;
constexpr size_t WS_APC = 303 * MiB;
constexpr size_t WS_APL = 320 * MiB;
constexpr size_t WS_END = 335 * MiB;
constexpr size_t APC_ML = (size_t)8192 * 4 * 2 * 64 * 4, APL_ML = (size_t)2048 * 4 * 7 * 64 * 4;

constexpr size_t O_Y = 0, O_CK = 10485760, O_CV = 12582912, O_SSD = 14680064, O_RET = 18874368;

constexpr int LDS_BYTES = 147456;

struct Args { const float* in[35]; float* out; unsigned char* ws; int ph_lo, ph_hi; };
typedef const __attribute__((address_space(4))) unsigned char* kargp_t;
__device__ __forceinline__ unsigned long long karg_u64(int off) { asm volatile("" : "+s"(off)); kargp_t kp = (kargp_t)__builtin_amdgcn_kernarg_segment_ptr(); return *(const __attribute__((address_space(4))) unsigned long long*)(kp + off); }
__device__ __forceinline__ int karg_i32(int off) { asm volatile("" : "+s"(off)); kargp_t kp = (kargp_t)__builtin_amdgcn_kernarg_segment_ptr(); return *(const __attribute__((address_space(4))) int*)(kp + off); }
#define INP(i) ((const float*)karg_u64(8 * (i)))
#define AOUT() ((float*)karg_u64(8 * 35))
#define AWS() ((unsigned char*)karg_u64(8 * 36))


#define LDS_WAIT() asm volatile("s_waitcnt lgkmcnt(0)" ::: "memory")
__device__ __forceinline__ float bf2f(unsigned short b) { return __uint_as_float(((unsigned)b) << 16); }
__device__ __forceinline__ unsigned f2bf(float f) { unsigned u = __float_as_uint(f); return (u + 0x7fffu + ((u >> 16) & 1u)) >> 16; }
__device__ __forceinline__ unsigned pk2(float lo, float hi) { return f2bf(lo) | (f2bf(hi) << 16); }
__device__ __forceinline__ float wave_sum(float v) {
#pragma unroll
    for (int o = 1; o < 64; o <<= 1) v += __shfl_xor(v, o);
    return v;
}
__device__ __forceinline__ float siluf(float v) { return v / (1.0f + __expf(-v)); }
__device__ __forceinline__ void seq_info(int sq, int& L, int& base) { if (sq < 32) { L = 256; base = sq * 256; } else { L = 1024; base = TCTX + (sq - 32) * 1024; } }

__device__ __forceinline__ void transpose_item(const float* __restrict__ W, int K, int Nsrc, bf16* WT, int k0, int n0, int drow0, LAS float* scr, int lane) {
    const int nn = n0 + (lane & 31); const bool ok = nn < Nsrc;
#pragma unroll 8
    for (int i = 0; i < 32; ++i) { const int kk = 2 * i + (lane >> 5); scr[kk * 33 + (lane & 31)] = ok ? W[(size_t)(k0 + kk) * Nsrc + nn] : 0.f; }
    LDS_WAIT();
    const int c = lane & 7;
#pragma unroll
    for (int j = 0; j < 4; ++j) { const int n = (lane >> 3) + 8 * j; const LAS float* s = scr + (8 * c) * 33 + n;
        u32x4 o; o.x = pk2(s[0 * 33], s[1 * 33]); o.y = pk2(s[2 * 33], s[3 * 33]); o.z = pk2(s[4 * 33], s[5 * 33]); o.w = pk2(s[6 * 33], s[7 * 33]);
        *(u32x4*)(WT + (size_t)(drow0 + n) * K + k0 + 8 * c) = o; }
    LDS_WAIT();
}

__device__ __forceinline__ void phase0(unsigned char* lds, int tid, int lane, int wave, int G) {
    const int bid = blockIdx.x;
    float* fl = (float*)lds;
    {
        const float* cc = INP(6); const float* cctx = INP(7); const float* wmod = INP(8); const float* bmod = INP(9);
        float* mod = (float*)(AWS() + WS_MOD);
        float* sc = fl;
        float* red = fl + 3072;
        for (int i = tid; i < 3072; i += NTHR) { const int ci = i >> 10, k = i & 1023; const float v = ci == 0 ? cctx[k] : cc[(ci - 1) * 1024 + k]; sc[i] = siluf(v); }
        __syncthreads();
        for (int it = bid; it < 288; it += G) {
            const int l = it / 144, col = (it % 144) * 64 + lane;
            const float* wp = wmod + ((size_t)l * 1024 + wave * 128) * 9216 + col;
            float a0 = 0.f, a1 = 0.f, a2 = 0.f;
#pragma unroll 8
            for (int k = 0; k < 128; ++k) { const float w = wp[(size_t)k * 9216]; const int kk = wave * 128 + k; a0 += sc[kk] * w; a1 += sc[1024 + kk] * w; a2 += sc[2048 + kk] * w; }
            red[(wave * 3 + 0) * 64 + lane] = a0; red[(wave * 3 + 1) * 64 + lane] = a1; red[(wave * 3 + 2) * 64 + lane] = a2;
            __syncthreads();
            if (tid < 192) { const int ci = tid >> 6, ln = tid & 63; float s = bmod[l * 9216 + (it % 144) * 64 + ln];
#pragma unroll
                for (int w = 0; w < 8; ++w) s += red[(w * 3 + ci) * 64 + ln];
                mod[((size_t)l * 3 + ci) * 9216 + (it % 144) * 64 + ln] = s; }
            __syncthreads();
        }
    }
    __syncthreads();
    {
        float* feats = fl;
        float* h1 = fl + 512;
        float* h2 = fl + 1024;
        const float MIN_DECAY = -3.0701134573253945f, MAX_DECAY = -15.350567286626973f;
        for (int it = bid; it < 320; it += G) {
            const int l = it / 160, r = it % 160; const int L = r < 32 ? 256 : 1024; const int pg = r < 32 ? r : r - 32;
            const float* w1 = INP(23) + l * 33 * 64; const float* b1 = INP(24) + l * 64; const float* w2 = INP(25) + l * 64 * 64; const float* b2 = INP(26) + l * 64;
            const float* w3 = INP(27) + (size_t)l * 64 * 1024; const float* fr = INP(28) + l * 64; const float* hb = INP(29) + l * 512;
            float* Hk = (float*)(AWS() + WS_HK + (size_t)l * HK_LAYER + (L == 256 ? 0 : HK1024_OFF));
            if (tid < 8 * 33) { const int pl = tid / 33, j = tid % 33; const float pos = (float)(pg * 8 + pl); float f;
                if (j == 0) f = pos / (float)(L - 1);
                else { const int b = (j - 1) & 15; const float band = 1e-4f + (float)b * ((15.0f - 1e-4f) / 15.0f); const float ang = (6.283185307179586f / (float)L) * pos * band; f = j <= 16 ? cosf(ang) : -sinf(ang); }
                feats[pl * 36 + j] = f; }
            __syncthreads();
            { const int pl = tid >> 6, j = tid & 63; float s = b1[j];
                for (int k = 0; k < 33; ++k) s += feats[pl * 36 + k] * w1[k * 64 + j];
                h1[pl * 64 + j] = sinf(fr[j] * s); }
            __syncthreads();
            { const int pl = tid >> 6, j = tid & 63; float s = b2[j];
                for (int k = 0; k < 64; ++k) s += h1[pl * 64 + k] * w2[k * 64 + j];
                h2[pl * 64 + j] = sinf(fr[j] * s); }
            __syncthreads();
#pragma unroll
            for (int cc = 0; cc < 2; ++cc) {
                const int col = tid + cc * 512;
                float acc[8];
#pragma unroll
                for (int p = 0; p < 8; ++p) acc[p] = 0.f;
                for (int k = 0; k < 64; ++k) { const float w = w3[k * 1024 + col];
#pragma unroll
                    for (int p = 0; p < 8; ++p) acc[p] += h2[p * 64 + k] * w; }
                const int c = col & 255, o = (col >> 8) & 1, dir = col >> 9;
                const float delta = fabsf(MIN_DECAY + (float)c * ((MAX_DECAY - MIN_DECAY) / 255.0f));
                float* Ho = Hk + (size_t)o * (2 * L - 1) * 256 + c;
#pragma unroll
                for (int p = 0; p < 8; ++p) { const int pos = pg * 8 + p; const float t = (float)pos / (float)(L - 1);
                    float v = acc[p] * __expf(-t * delta);
                    if (dir == 0) { if (pos == 0) v += hb[o * 256 + c]; Ho[(size_t)(L - 1 + pos) * 256] = v; }
                    else if (pos > 0) Ho[(size_t)(L - 1 - pos) * 256] = v; }
            }
            __syncthreads();
        }
    }
    __syncthreads();
    {
        LAS float* scr = (LAS float*)((LAS unsigned char*)lds + wave * 16384);
        const int gw = bid * NWAVES + wave, NGW = G * NWAVES;
        constexpr int I_IN = 16 * 176, I_OUT = 44 * 32, I_MI = 16 * 112, I_MO = 16 * 32, I_LAYER = 2 * I_IN + 2 * I_OUT + I_MI + I_MO;
        for (int it = gw; it < 2 * I_LAYER; it += NGW) {
            const int l = it / I_LAYER; int r = it % I_LAYER;
            unsigned char* wl = AWS() + WS_W + (size_t)l * W_LAYER;
            if (r < 2 * I_IN) { const int f = r / I_IN; r %= I_IN; const int kb = r / 176, nb = r % 176, n0 = nb * 32;
                const int isup = n0 >= DFF, ff = isup ? n0 - DFF : n0; const int drow0 = (ff >> 7) * 256 + isup * 128 + (ff & 127);
                transpose_item(INP(11) + (size_t)(l * 2 + f) * 1024 * 5632, 1024, 5632, (bf16*)(wl + (f ? W_IN1 : W_IN0)), kb * 64, n0, drow0, scr, lane); continue; }
            r -= 2 * I_IN;
            if (r < 2 * I_OUT) { const int f = r / I_OUT; r %= I_OUT; const int kb = r / 32, nb = r % 32;
                transpose_item(INP(12) + (size_t)(l * 2 + f) * 2816 * 1024, 2816, 1024, (bf16*)(wl + (f ? W_OUT1 : W_OUT0)), kb * 64, nb * 32, nb * 32, scr, lane); continue; }
            r -= 2 * I_OUT;
            if (r < I_MI) { const int kb = r / 112, nb = r % 112;
                transpose_item(INP(13) + (size_t)l * 1024 * DIN, 1024, DIN, (bf16*)(wl + W_MI), kb * 64, nb * 32, nb * 32, scr, lane); continue; }
            r -= I_MI;
            { const int kb = r / 32, nb = r % 32;
                transpose_item(INP(14) + (size_t)l * 1024 * 1024, 1024, 1024, (bf16*)(wl + W_MO), kb * 64, nb * 32, nb * 32, scr, lane); }
        }
    }
}

__device__ __forceinline__ void prep_phase(const float* xc, const float* xl, const float* nw, const float* modl, int p, bf16* H, int gw, int NGW, int lane) {
    f32x4 wv[4];
#pragma unroll
    for (int j = 0; j < 4; ++j) wv[j] = *(const f32x4*)(nw + 4 * lane + 256 * j);
    for (int row = gw; row < TT; row += NGW) {
        const float* x = (row < TCTX ? xc : xl) + (size_t)row * D;
        const int cidx = row < TCTX ? 0 : 1 + ((row - TCTX) >> 10);
        const float* sh = modl + (size_t)cidx * 9216 + (3 * p) * 1024; const float* sc = sh + 1024;
        f32x4 v[4]; float ss = 0.f;
#pragma unroll
        for (int j = 0; j < 4; ++j) { v[j] = *(const f32x4*)(x + 4 * lane + 256 * j); ss += (v[j].x * v[j].x + v[j].y * v[j].y) + (v[j].z * v[j].z + v[j].w * v[j].w); }
        const float rstd = rsqrtf(wave_sum(ss) * (1.0f / D) + EPS);
#pragma unroll
        for (int j = 0; j < 4; ++j) { const f32x4 s1 = *(const f32x4*)(sc + 4 * lane + 256 * j), s0 = *(const f32x4*)(sh + 4 * lane + 256 * j);
            const f32x4 y = (v[j] * rstd * wv[j]) * (s1 + 1.0f) + s0;
            u32x2 o; o.x = pk2(y.x, y.y); o.y = pk2(y.z, y.w);
            *(u32x2*)(H + (size_t)row * D + 4 * lane + 256 * j) = o; }
    }
}

__device__ __forceinline__ void m1_phase(int li, int gw, int NGW, int lane) {
    const bf16* U = (const bf16*)(AWS() + WS_UA);
    float* XBC = (float*)(AWS() + WS_XBC); float* QK = (float*)(AWS() + WS_QK);
    const float* cw = INP(15) + li * 3 * 768; const float* cb = INP(16) + li * 768;
    const float* qw = INP(32) + li * 64; const float* kw = INP(33) + li * 64;
    const float qwl = qw[lane], kwl = kw[lane];
    const int hf = lane >> 5, ri = lane & 31, fi = ri & 15;
    const float inv = exp2f(-(float)fi * (13.287712379549449f / 16.0f));
    for (int tok = gw; tok < TT; tok += NGW) {
        int sq, pos, L;
        if (tok < TCTX) { sq = tok >> 8; pos = tok & 255; L = 256; } else { sq = 32 + ((tok - TCTX) >> 10); pos = (tok - TCTX) & 1023; L = 1024; }
        const bf16* ur = U + (size_t)tok * DINP;
#pragma unroll
        for (int i = 0; i < 12; ++i) { const int ch = lane + 64 * i;
            const float c0 = bf2f(ur[U_XBC + ch]);
            const float cm = pos > 0 ? bf2f(ur[U_XBC + ch - DINP]) : 0.f;
            const float cp = pos < L - 1 ? bf2f(ur[U_XBC + ch + DINP]) : 0.f;
            const float v = cb[ch] + cw[ch] * cm + cw[768 + ch] * c0 + cw[1536 + ch] * cp;
            XBC[(size_t)tok * 768 + ch] = siluf(v); }
        float sn = 0.f, cs = 1.f;
        if (sq >= 32) { const float pv = hf ? (float)(pos & 63) : (float)(pos >> 6); sincosf(pv * inv, &sn, &cs); }
#pragma unroll
        for (int h = 0; h < 6; ++h) {
            const float x = bf2f(ur[U_ATT + h * 64 + lane]);
            const float ss = wave_sum(x * x);
            float y = x * rsqrtf(ss * (1.0f / 64.0f) + EPS) * (h < 4 ? qwl : kwl);
            if (h >= 4 && sq < 32) AOUT()[O_CK + ((((size_t)sq * 2 + li) * 256 + pos) * 2 + (h - 4)) * 64 + lane] = y;
            if (sq >= 32) { const float yp = __shfl_xor(y, 16); y = (ri < 16) ? y * cs - yp * sn : yp * sn + y * cs; }
            QK[(size_t)tok * 384 + h * 64 + lane] = y;
        }
        if (sq < 32) {
#pragma unroll
            for (int kv = 0; kv < 2; ++kv) AOUT()[O_CV + ((((size_t)sq * 2 + li) * 256 + pos) * 2 + kv) * 64 + lane] = bf2f(ur[U_ATT + 384 + kv * 64 + lane]);
        }
    }
}

template <int N, bool SSD>
__device__ __forceinline__ void scan_item(int li, int sq, int h, int dir, unsigned char* lds, int tid, int lane, int wave) {
    constexpr int TC = 32, G = (2 * N + 64) / 4, R = (TC * G) / NTHR, NPL = N / 8;
    constexpr int CHF = TC * (2 * N + 64) + 64;
    static_assert((TC * G) % NTHR == 0, "chunk loader");
    int L, base; seq_info(sq, L, base);
    float* buf = (float*)lds;
    const float* XBC = (const float*)(AWS() + WS_XBC); const bf16* U = (const bf16*)(AWS() + WS_UA);
    float* Y = (float*)(AWS() + (SSD ? WS_YS : WS_YR)) + (size_t)dir * TT * 256;
    const int g = h >> 1;
    float pA = 0.f, pK = 0.f;
    float dtb = 0.f, aneg = 0.f;
    if (SSD) { dtb = INP(17)[(li * 2 + dir) * 4 + h]; aneg = -__expf(INP(18)[(li * 2 + dir) * 4 + h]); }
    else { const float dl = INP(30)[(li * 2 + dir) * 4 + h]; pA = 1.0f / (1.0f + __expf(-dl)); pK = 0.125f; }
    f32x4 pre[R];
    const int nch = L / TC;
    auto issue = [&](int ch) {
#pragma unroll
        for (int r = 0; r < R; ++r) { const int gi0 = tid + NTHR * r, j = gi0 / G, gi = gi0 % G; const int s = ch * TC + j, pos = dir ? L - 1 - s : s; const size_t tok = (size_t)base + pos;
            if (SSD) { const int col = gi < N / 4 ? 512 + g * 128 + 4 * gi : (gi < N / 2 ? 256 + g * 128 + 4 * (gi - N / 4) : h * 64 + 4 * (gi - N / 2));
                pre[r] = *(const f32x4*)(XBC + tok * 768 + col); }
            else { const int col = U_RET + (gi < N / 4 ? h * 64 + 4 * gi : (gi < N / 2 ? 256 + h * 64 + 4 * (gi - N / 4) : 512 + h * 64 + 4 * (gi - N / 2)));
                const u16x4 w = *(const u16x4*)(U + tok * DINP + col); pre[r] = (f32x4){bf2f(w.x), bf2f(w.y), bf2f(w.z), bf2f(w.w)}; } }
        if (SSD && tid < TC) { const int s = ch * TC + tid, pos = dir ? L - 1 - s : s; const float x = bf2f(U[((size_t)base + pos) * DINP + U_DT + dir * 4 + h]) + dtb;
            const float dt = x > 20.f ? x : log1pf(__expf(x)); pK = dt; pA = __expf(dt * aneg); }
    };
    auto commit = [&](int bsel) {
        float* b = buf + bsel * CHF;
#pragma unroll
        for (int r = 0; r < R; ++r) { const int gi0 = tid + NTHR * r, j = gi0 / G, gi = gi0 % G;
            const int off = gi < N / 4 ? j * N + 4 * gi : (gi < N / 2 ? TC * N + j * N + 4 * (gi - N / 4) : 2 * TC * N + j * 64 + 4 * (gi - N / 2));
            *(f32x4*)(b + off) = pre[r]; }
        if (tid < TC) { b[TC * (2 * N + 64) + tid] = pA; b[TC * (2 * N + 64) + 32 + tid] = pK; }
    };
    const int pl = lane >> 3, ns = lane & 7, p = wave * 8 + pl;
    float S[NPL];
    if (sq < 32) {
#pragma unroll
        for (int i = 0; i < NPL; ++i) S[i] = 0.f;
    } else {
        const float* s0 = INP(SSD ? 4 : 5) + ((((size_t)(sq - 32) * 2 + li) * 2 + dir) * 4 + h) * (size_t)(N * 64);
#pragma unroll
        for (int i = 0; i < NPL; ++i) S[i] = s0[(ns * NPL + i) * 64 + p];
    }
    issue(0);
    __syncthreads();
    commit(0);
    __syncthreads();
    for (int ch = 0; ch < nch; ++ch) {
        if (ch + 1 < nch) issue(ch + 1);
        const float* b = buf + (ch & 1) * CHF;
        const float* Qs = b, *Ks = b + TC * N, *Vs = b + 2 * TC * N, *As = b + TC * (2 * N + 64), *KSs = As + 32;
        for (int j = 0; j < TC; ++j) {
            const float av = As[j], kv = KSs[j] * Vs[j * 64 + p];
            float y = 0.f;
#pragma unroll
            for (int i4 = 0; i4 < NPL / 4; ++i4) { const f32x4 k4 = *(const f32x4*)(Ks + j * N + ns * NPL + 4 * i4), q4 = *(const f32x4*)(Qs + j * N + ns * NPL + 4 * i4);
#pragma unroll
                for (int e = 0; e < 4; ++e) { S[4 * i4 + e] = av * S[4 * i4 + e] + k4[e] * kv; y += q4[e] * S[4 * i4 + e]; } }
            y += __shfl_xor(y, 1); y += __shfl_xor(y, 2); y += __shfl_xor(y, 4);
            if (ns == 0) { const int s = ch * TC + j, pos = dir ? L - 1 - s : s; Y[((size_t)base + pos) * 256 + h * 64 + p] = y; }
        }
        if (ch + 1 < nch) commit((ch + 1) & 1);
        __syncthreads();
    }
    if (sq < 32) {
        float* so = AOUT() + (SSD ? O_SSD : O_RET) + ((((size_t)sq * 2 + li) * 2 + dir) * 4 + h) * (size_t)(N * 64);
#pragma unroll
        for (int i = 0; i < NPL; ++i) so[(ns * NPL + i) * 64 + p] = S[i];
    }
}

__device__ __forceinline__ void attn_item(int li, int sq, int kvh, int qb, int kt, unsigned char* lds, int tid, int lane, int wave) {
    int L, base; seq_info(sq, L, base);
    const bool lat = sq >= 32;
    const float* QK = (const float*)(AWS() + WS_QK); const bf16* U = (const bf16*)(AWS() + WS_UA);
    float* Ks = (float*)lds; float* Vs = Ks + 128 * 64;
    const int kb = qb + kt - 5;
    __syncthreads();
#pragma unroll
    for (int r = 0; r < 4; ++r) { const int e = tid + NTHR * r, j = e >> 4, c4 = (e & 15) * 4;
        f32x4 kq, vq;
        if (lat && kt < 4) { const size_t ci = ((((size_t)(sq - 32) * 2 + li) * 512 + kt * 128 + j) * 2 + kvh) * 64 + c4; kq = *(const f32x4*)(INP(2) + ci); vq = *(const f32x4*)(INP(3) + ci); }
        else { const size_t tok = (size_t)base + (lat ? kb : kt) * 128 + j; kq = *(const f32x4*)(QK + tok * 384 + 256 + kvh * 64 + c4);
            const u16x4 w = *(const u16x4*)(U + tok * DINP + U_ATT + 384 + kvh * 64 + c4); vq = (f32x4){bf2f(w.x), bf2f(w.y), bf2f(w.z), bf2f(w.w)}; }
        *(f32x4*)(Ks + j * 64 + c4) = kq; *(f32x4*)(Vs + j * 64 + c4) = vq; }
    const int pair = tid & 255, khalf = tid >> 8, qi = pair & 127, hh = pair >> 7, head = kvh * 2 + hh;
    const size_t qtok = (size_t)base + qb * 128 + qi;
    f32x4 q[16], o[16];
#pragma unroll
    for (int i = 0; i < 16; ++i) { q[i] = *(const f32x4*)(QK + qtok * 384 + head * 64 + 4 * i) * 0.125f; o[i] = (f32x4){0.f, 0.f, 0.f, 0.f}; }
    float m = -1e30f, l = 0.f;
    __syncthreads();
    const bool masked = lat && kt >= 4;
    const int qpos = qb * 128 + qi;
    for (int jj = 0; jj < 64; ++jj) {
        const int j = khalf * 64 + jj;
        f32x4 sa = (f32x4){0.f, 0.f, 0.f, 0.f};
#pragma unroll
        for (int i = 0; i < 16; ++i) sa += q[i] * *(const f32x4*)(Ks + j * 64 + 4 * i);
        const float s = (sa.x + sa.y) + (sa.z + sa.w);
        bool valid = true;
        if (masked) { const int d = qpos - (kb * 128 + j); valid = (d <= 128) && (d >= -128); }
        if (valid) {
            if (s > m) { const float corr = __expf(m - s); l *= corr;
#pragma unroll
                for (int i = 0; i < 16; ++i) o[i] *= corr;
                m = s; }
            const float pexp = __expf(s - m); l += pexp;
#pragma unroll
            for (int i = 0; i < 16; ++i) o[i] += pexp * *(const f32x4*)(Vs + j * 64 + 4 * i);
        }
    }
    __syncthreads();
    float* mg = (float*)lds + pair * 68;
    if (khalf == 1) { mg[0] = m; mg[1] = l;
#pragma unroll
        for (int i = 0; i < 16; ++i) *(f32x4*)(mg + 4 + 4 * i) = o[i]; }
    __syncthreads();
    if (khalf == 0) { const float m1 = mg[0], l1 = mg[1]; const float M = fmaxf(m, m1), c0 = __expf(m - M), c1 = __expf(m1 - M);
        mg[0] = M; mg[1] = l * c0 + l1 * c1;
#pragma unroll
        for (int i = 0; i < 16; ++i) { const f32x4 o1 = *(const f32x4*)(mg + 4 + 4 * i); *(f32x4*)(mg + 4 + 4 * i) = o[i] * c0 + o1 * c1; } }
    __syncthreads();
    float* OP = (float*)(AWS() + (lat ? WS_APL : WS_APC)); float* MLp = (float*)(AWS() + (lat ? WS_APL + APL_ML : WS_APC + APC_ML));
    const int NS = lat ? 7 : 2; const size_t tb = lat ? (size_t)(base - TCTX) : (size_t)base;
    for (int pr = wave * 32; pr < wave * 32 + 32; ++pr) { const int qq = pr & 127, hd = kvh * 2 + (pr >> 7);
        const size_t idx = ((tb + qb * 128 + qq) * 4 + hd) * NS + kt; const float* src = (const float*)lds + pr * 68;
        OP[idx * 64 + lane] = src[4 + lane];
        if (lane < 2) MLp[idx * 2 + lane] = src[lane]; }
}

template <int ORDER>
__device__ __forceinline__ void hyena_item(int li, int sq, int cgp, int tt, int lane) {
    int L, base; seq_info(sq, L, base);
    const int c = cgp * 64 + lane, t0 = tt * 16;
    const float* Hk = (const float*)(AWS() + WS_HK + (size_t)li * HK_LAYER + (L == 256 ? 0 : HK1024_OFF)) + (size_t)ORDER * (2 * L - 1) * 256 + c;
    const bf16* U = (const bf16*)(AWS() + WS_UA); const float* Z1 = (const float*)(AWS() + WS_Z1);
    const float* cw = INP(21) + li * 3 * 768; const float* cb = INP(22) + li * 768;
    const float w0 = cw[c], w1 = cw[768 + c], w2 = cw[1536 + c], b0 = cb[c];
    float acc[16];
#pragma unroll
    for (int i = 0; i < 16; ++i) acc[i] = 0.f;
    for (int s0 = 0; s0 < L; s0 += 16) {
        float W[31], z[16];
        const int l0 = t0 - s0 + L - 1 - 15;
#pragma unroll
        for (int m = 0; m < 31; ++m) W[m] = Hk[(size_t)(l0 + m) * 256];
        if (ORDER == 0) {
            float ur[18];
#pragma unroll
            for (int i = 0; i < 18; ++i) { const int s = s0 - 1 + i; ur[i] = (s >= 0 && s < L) ? bf2f(U[((size_t)base + s) * DINP + U_HY + c]) : 0.f; }
#pragma unroll
            for (int j = 0; j < 16; ++j) z[j] = b0 + w0 * ur[j] + w1 * ur[j + 1] + w2 * ur[j + 2];
        } else {
#pragma unroll
            for (int j = 0; j < 16; ++j) z[j] = Z1[((size_t)base + s0 + j) * 256 + c];
        }
#pragma unroll
        for (int j = 0; j < 16; ++j)
#pragma unroll
            for (int i = 0; i < 16; ++i) acc[i] += W[15 - j + i] * z[j];
    }
    const int cx = 256 * (ORDER + 1) + c;
    const float v0 = cw[cx], v1 = cw[768 + cx], v2 = cw[1536 + cx], vb = cb[cx];
    float ur[18];
#pragma unroll
    for (int i = 0; i < 18; ++i) { const int s = t0 - 1 + i; ur[i] = (s >= 0 && s < L) ? bf2f(U[((size_t)base + s) * DINP + U_HY + cx]) : 0.f; }
#pragma unroll
    for (int i = 0; i < 16; ++i) { const float xm = vb + v0 * ur[i] + v1 * ur[i + 1] + v2 * ur[i + 2]; const float r = xm * acc[i];
        if (ORDER == 0) ((float*)(AWS() + WS_Z1))[((size_t)base + t0 + i) * 256 + c] = r;
        else ((bf16*)(AWS() + WS_YMIX))[((size_t)base + t0 + i) * D + 256 + c] = (bf16)f2bf(r); }
}

__device__ __forceinline__ void finalize_token(int li, int tok, int lane) {
    const bf16* ur = (const bf16*)(AWS() + WS_UA) + (size_t)tok * DINP;
    bf16* ym = (bf16*)(AWS() + WS_YMIX) + (size_t)tok * D;
    const float* YS = (const float*)(AWS() + WS_YS); const float* YR = (const float*)(AWS() + WS_YR); const float* XBC = (const float*)(AWS() + WS_XBC);
    const int ch0 = lane * 4, hd = lane >> 4;
    {
        const f32x4 yf = *(const f32x4*)(YS + (size_t)tok * 256 + ch0), yb = *(const f32x4*)(YS + ((size_t)TT + tok) * 256 + ch0), xs = *(const f32x4*)(XBC + (size_t)tok * 768 + ch0);
        const u16x4 zw = *(const u16x4*)(ur + U_Z + ch0);
        const float dsk = INP(19)[li * 4 + hd];
        f32x4 y = yf + yb + xs * dsk;
        y.x *= siluf(bf2f(zw.x)); y.y *= siluf(bf2f(zw.y)); y.z *= siluf(bf2f(zw.z)); y.w *= siluf(bf2f(zw.w));
        const float ss = wave_sum((y.x * y.x + y.y * y.y) + (y.z * y.z + y.w * y.w));
        const float rstd = rsqrtf(ss * (1.0f / 256.0f) + EPS);
        const f32x4 nw = *(const f32x4*)(INP(20) + li * 256 + ch0);
        y = y * rstd * nw;
        u32x2 o; o.x = pk2(y.x, y.y); o.y = pk2(y.z, y.w); *(u32x2*)(ym + ch0) = o;
    }
    {
        const f32x4 yf = *(const f32x4*)(YR + (size_t)tok * 256 + ch0), yb = *(const f32x4*)(YR + ((size_t)TT + tok) * 256 + ch0);
        f32x4 y = yf + yb;
        float s = (y.x + y.y) + (y.z + y.w);
        s += __shfl_xor(s, 1); s += __shfl_xor(s, 2); s += __shfl_xor(s, 4); s += __shfl_xor(s, 8);
        const float mu = s * (1.0f / 64.0f);
        y = y - mu;
        float q = (y.x * y.x + y.y * y.y) + (y.z * y.z + y.w * y.w);
        q += __shfl_xor(q, 1); q += __shfl_xor(q, 2); q += __shfl_xor(q, 4); q += __shfl_xor(q, 8);
        const float rstd = rsqrtf(q * (1.0f / 64.0f) + EPS);
        const f32x4 gw = *(const f32x4*)(INP(31) + li * 256 + ch0);
        const u16x4 gg = *(const u16x4*)(ur + U_RET + 768 + ch0);
        y = y * rstd * gw;
        y.x *= siluf(bf2f(gg.x)); y.y *= siluf(bf2f(gg.y)); y.z *= siluf(bf2f(gg.z)); y.w *= siluf(bf2f(gg.w));
        u32x2 o; o.x = pk2(y.x, y.y); o.y = pk2(y.z, y.w); *(u32x2*)(ym + 512 + ch0) = o;
    }
    {
        const bool lat = tok >= TCTX;
        const float* OP = (const float*)(AWS() + (lat ? WS_APL : WS_APC)); const float* MLp = (const float*)(AWS() + (lat ? WS_APL + APL_ML : WS_APC + APC_ML));
        const int NS = lat ? 7 : 2; const size_t tb = lat ? (size_t)(tok - TCTX) : (size_t)tok;
        const int qb = lat ? (((tok - TCTX) & 1023) >> 7) : 0;
#pragma unroll
        for (int h = 0; h < 4; ++h) {
            const size_t idx = (tb * 4 + h) * NS;
            float ms = -1e30f, ls = 0.f;
            const bool sv = lane < NS && !(lat && ((lane == 4 && qb == 0) || (lane == 6 && qb == 7)));
            if (sv) { const f32x2 t = *(const f32x2*)(MLp + (idx + lane) * 2); ms = t.x; ls = t.y; }
            const float sink = INP(34)[li * 4 + h];
            float M = ms;
#pragma unroll
            for (int o = 1; o < 8; o <<= 1) M = fmaxf(M, __shfl_xor(M, o));
            M = fmaxf(M, sink);
            const float w = sv ? __expf(ms - M) : 0.f;
            float den = w * ls;
#pragma unroll
            for (int o = 1; o < 8; o <<= 1) den += __shfl_xor(den, o);
            den += __expf(sink - M);
            den = __shfl(den, 0);
            float ov = 0.f;
            for (int s = 0; s < NS; ++s) { const float ws_ = __shfl(w, s); if (ws_ != 0.f) ov += ws_ * OP[(idx + s) * 64 + lane]; }
            ym[768 + h * 64 + lane] = (bf16)f2bf(ov / den);
        }
    }
}

__device__ __forceinline__ int dq_next(unsigned* ctr, volatile int* slot, int tid) {
    __syncthreads();
    if (tid == 0) *slot = (int)__hip_atomic_fetch_add(ctr, 1u, __ATOMIC_RELAXED, __HIP_MEMORY_SCOPE_AGENT);
    __syncthreads();
    return *slot;
}

__global__ void __launch_bounds__(NTHR, 2) mk_fwd(Args a) {
    extern __shared__ __attribute__((aligned(16))) unsigned char lds[];
    const int ph_hi = karg_i32(8 * 37 + 4);
    for (int ph = karg_i32(8 * 37); ph < ph_hi; ++ph) {
        int tid = threadIdx.x; asm volatile("" : "+v"(tid));
        int G = gridDim.x, bid = blockIdx.x; asm volatile("" : "+s"(G), "+s"(bid));
        const int lane = tid & 63, wave = __builtin_amdgcn_readfirstlane(tid >> 6);
        const int gw = bid * NWAVES + wave, NGW = G * NWAVES;
        unsigned* ctl = (unsigned*)(AWS() + WS_CTL);
        volatile int* qslot = (volatile int*)(lds + 131072 + 64);
        float* xbuf = AOUT() + O_Y;
        if (ph == 0) {
            if (EN(0)) phase0(lds, tid, lane, wave, G);
        } else if (ph == NPHASE) {
            float* o = AOUT();
#define ZERO_OUT(i, lo, hi) if (!((MK_KEEP >> (i)) & 1)) for (size_t e = (size_t)(lo) + (size_t)bid * NTHR + tid; e < (size_t)(hi); e += (size_t)G * NTHR) o[e] = 0.f;
            ZERO_OUT(0, 0, 8388608) ZERO_OUT(1, 8388608, 10485760) ZERO_OUT(2, 10485760, 12582912) ZERO_OUT(3, 12582912, 14680064) ZERO_OUT(4, 14680064, 18874368) ZERO_OUT(5, 18874368, 20971520)
        } else {
            const int li = (ph - 1) / 12, k = (ph - 1) % 12;
            const float* modl = (const float*)(AWS() + WS_MOD) + (size_t)li * 3 * 9216;
            unsigned char* wl = AWS() + WS_W + (size_t)li * W_LAYER;
            const bool first = (li == 0 && k <= 2);
            const float* xc = first ? INP(0) : xbuf;
            const float* xl = first ? INP(1) - (size_t)TCTX * D : xbuf;
            if (k == 0 || k == 3 || k == 9) {
                const int p = k == 0 ? 0 : (k == 3 ? 1 : 2);
                if (EN(1)) prep_phase(xc, xl, INP(10) + (li * 3 + p) * 1024, modl, p, (bf16*)(AWS() + WS_H), gw, NGW, lane);
            } else if (k == 1 || k == 10) {
                pg8::Gemm g{(const bf16*)(AWS() + WS_H), (const bf16*)(wl + (k == 1 ? W_IN0 : W_IN1)), TT, 2 * DFF, D};
                pg8::StaticOrder S; S.init(TT, 2 * DFF, G, bid);
                pg8::EpiSwiglu E{(bf16*)(AWS() + WS_UA), DFF};
                if (EN(2)) pg8::gemm_phase<pg8::EpiSwiglu, pg8::StaticOrder, true, true>((LAS unsigned char*)lds, g, S, E, tid);
            } else if (k == 2 || k == 8 || k == 11) {
                const bool mix = (k == 8);
                pg8::Gemm g{(const bf16*)(AWS() + (mix ? WS_YMIX : WS_UA)), (const bf16*)(wl + (mix ? W_MO : (k == 2 ? W_OUT0 : W_OUT1))), TT, D, mix ? D : DFF};
                pg8::StaticOrder S; S.init(TT, D, G, bid);
                const int gi = k == 2 ? 2 : (k == 8 ? 5 : 8);
                pg8::EpiResid E{xc, xl, xbuf, modl + gi * 1024, mix ? 1.0f : 0.5f};
                if (EN(3)) pg8::gemm_phase<pg8::EpiResid, pg8::StaticOrder, true, true>((LAS unsigned char*)lds, g, S, E, tid);
            } else if (k == 4) {
                pg8::Gemm g{(const bf16*)(AWS() + WS_H), (const bf16*)(wl + W_MI), TT, DINP, D};
                pg8::StaticOrder S; S.init(TT, DINP, G, bid);
                pg8::EpiBf16 E{(bf16*)(AWS() + WS_UA), DINP};
                if (EN(4)) pg8::gemm_phase<pg8::EpiBf16, pg8::StaticOrder, true, true>((LAS unsigned char*)lds, g, S, E, tid);
            } else if (k == 5) {
                if (EN(5)) m1_phase(li, gw, NGW, lane);
            } else if (k == 6) {
                for (;;) {
                    int it = dq_next(ctl + ph, qslot, threadIdx.x);
                    if (it >= 1344) break;
                    int tid = threadIdx.x, li = (ph - 1) / 12; asm volatile("" : "+v"(tid)); asm volatile("" : "+s"(li));
                    const int lane = tid & 63, wave = __builtin_amdgcn_readfirstlane(tid >> 6);
                    if (it < 16) { if (EN(6)) scan_item<128, true>(li, 32 + (it >> 3), (it >> 1) & 3, it & 1, lds, tid, lane, wave); continue; } it -= 16;
                    if (it < 16) { if (EN(7)) scan_item<64, false>(li, 32 + (it >> 3), (it >> 1) & 3, it & 1, lds, tid, lane, wave); continue; } it -= 16;
                    if (it < 64) { if (EN(9)) hyena_item<0>(li, 32 + (it >> 5), (it >> 3) & 3, (it & 7) * 8 + wave, lane); continue; } it -= 64;
                    if (it < 256) { if (EN(6)) scan_item<128, true>(li, it >> 3, (it >> 1) & 3, it & 1, lds, tid, lane, wave); continue; } it -= 256;
                    if (it < 224) { const int kt = it % 7, r = it / 7, qb = r & 7, kvh = (r >> 3) & 1, b = r >> 4;
                        if ((kt == 4 && qb == 0) || (kt == 6 && qb == 7)) continue;
                        if (EN(8)) attn_item(li, 32 + b, kvh, qb, kt, lds, tid, lane, wave); continue; } it -= 224;
                    if (it < 256) { if (EN(7)) scan_item<64, false>(li, it >> 3, (it >> 1) & 3, it & 1, lds, tid, lane, wave); continue; } it -= 256;
                    if (it < 256) { if (EN(8)) attn_item(li, it >> 3, (it >> 2) & 1, (it >> 1) & 1, it & 1, lds, tid, lane, wave); continue; } it -= 256;
                    if (EN(9)) hyena_item<0>(li, it >> 3, (it >> 1) & 3, (it & 1) * 8 + wave, lane);
                }
            } else if (k == 7) {
                for (;;) {
                    int it = dq_next(ctl + ph, qslot, threadIdx.x);
                    if (it >= 1600) break;
                    int tid = threadIdx.x, li = (ph - 1) / 12; asm volatile("" : "+v"(tid)); asm volatile("" : "+s"(li));
                    const int lane = tid & 63, wave = __builtin_amdgcn_readfirstlane(tid >> 6);
                    if (it < 64) { if (EN(10)) hyena_item<1>(li, 32 + (it >> 5), (it >> 3) & 3, (it & 7) * 8 + wave, lane); continue; } it -= 64;
                    if (it < 256) { if (EN(10)) hyena_item<1>(li, it >> 3, (it >> 1) & 3, (it & 1) * 8 + wave, lane); continue; } it -= 256;
                    if (EN(11)) finalize_token(li, it * 8 + wave, lane);
                }
            }
        }
        if (ph + 1 < ph_hi) { cg::this_grid().sync(); }
    }

}

extern "C" void kernel_launch(void* const* d_in, const int* in_sizes, int n_in, void* d_out, int out_size, void* d_ws, size_t ws_size, hipStream_t stream) {
    static int grid = 0;
    if (grid == 0) {
        if (n_in != 35 || ws_size < WS_END) { fprintf(stderr, "kernel_launch: unexpected n_in %d / ws %zu\n", n_in, ws_size); grid = -1; return; }
        int dev = 0, cus = 0, per_cu = 0;
        hipGetDevice(&dev);
        hipDeviceGetAttribute(&cus, hipDeviceAttributeMultiprocessorCount, dev);
        if (hipFuncSetAttribute((const void*)mk_fwd, hipFuncAttributeMaxDynamicSharedMemorySize, LDS_BYTES) != hipSuccess) { fprintf(stderr, "kernel_launch: hipFuncSetAttribute failed\n"); grid = -1; return; }
        if (hipOccupancyMaxActiveBlocksPerMultiprocessor(&per_cu, (const void*)mk_fwd, NTHR, LDS_BYTES) != hipSuccess || per_cu < 1) { fprintf(stderr, "kernel_launch: occupancy query says %d\n", per_cu); per_cu = 1; }
        (void)hipGetLastError();
        if (per_cu > 1) per_cu = 1;
        grid = cus * per_cu;
    }
    if (grid < 0) return;
    hipMemsetAsync((char*)d_ws + WS_CTL, 0, CTL_ZERO_BYTES, stream);
    Args a{};
    for (int i = 0; i < 35; ++i) a.in[i] = (const float*)d_in[i];
    a.out = (float*)d_out; a.ws = (unsigned char*)d_ws;
#if MK_MULTI
    for (int ph = 0; ph < NPHASE; ++ph) { a.ph_lo = ph; a.ph_hi = ph + 1; hipLaunchKernelGGL(mk_fwd, dim3(grid), dim3(NTHR), LDS_BYTES, stream, a); }
#else
    a.ph_lo = 0; a.ph_hi = NPHASE + (MK_KEEP != 0x3F ? 1 : 0);
    void* args[] = {&a};
    hipError_t e = hipLaunchCooperativeKernel((const void*)mk_fwd, dim3(grid), dim3(NTHR), args, LDS_BYTES, stream);
    if (e != hipSuccess) fprintf(stderr, "cooperative launch failed: %s (grid %d)\n", hipGetErrorString(e), grid);
#endif
}
```

```cpp
#include <hip/hip_runtime.h>
#include <hip/hip_cooperative_groups.h>
#include <cstdio>
#include <cstdint>
namespace cg = cooperative_groups;

#ifndef MK_EN
#define MK_EN 0xFFFF
#endif
#define EN(b) ((MK_EN >> (b)) & 1)
#ifndef MK_KEEP
#define MK_KEEP 0x3F
#endif
#ifndef MK_MULTI
#define MK_MULTI 0
#endif

#define GAS __attribute__((address_space(1)))
#define LAS __attribute__((address_space(3)))
typedef unsigned short bf16;
typedef float f32x4 __attribute__((ext_vector_type(4)));
typedef float f32x2 __attribute__((ext_vector_type(2)));
typedef unsigned u32x4 __attribute__((ext_vector_type(4)));
typedef unsigned u32x2 __attribute__((ext_vector_type(2)));
typedef unsigned short u16x4 __attribute__((ext_vector_type(4)));

namespace pg8 {
#define PG8_LAS __attribute__((address_space(3)))
typedef unsigned short bf16_t;
typedef short bf16x8 __attribute__((ext_vector_type(8)));
constexpr int BM = 256, BK = 64, HALF = 128, HTB = HALF * BK * 2, STAGE_BYTES = 8 * HTB, NXCD = 8, WGM = 8;

__host__ __device__ __forceinline__ int lds_byte(int r, int c) { const int st = (r >> 4) * 2 + (c >> 5), rr = r & 15, cc = c & 31, ob = rr * 64 + cc * 2; return st * 1024 + (ob ^ (((ob >> 9) & 1) << 5)); }
__host__ __device__ __forceinline__ void stage_rc(int b, int& R, int& C) { const int st = b / 1024, sb = b % 1024, swz = sb ^ (((sb >> 9) & 1) << 5); R = (st >> 1) * 16 + swz / 64; C = (st & 1) * 32 + (swz % 64) / 2; }
__host__ __device__ __forceinline__ int perm32(int rho) { const int n = rho >> 4, i = rho & 15; return 8 * (i >> 2) + 4 * n + (i & 3); }

struct Unit { int pm, pn; };
struct Gemm { const bf16_t* A; const bf16_t* Bt; int M, N, K; };

struct StaticOrder {
    int nM, nN, nwg, G, c;
    __host__ __device__ void init(int M, int N, int G_, int c_) { nM = M / BM; nN = N / BM; nwg = nM * nN; G = G_; c = c_; }
    __host__ __device__ bool next(int i, Unit& u) const {
        const long L = (long)i * G + c; if (L >= nwg) return false;
        int wgid = (int)L; { const int q = nwg / NXCD, r = nwg % NXCD, xcd = wgid % NXCD, off = wgid / NXCD; wgid = (xcd < r ? xcd * (q + 1) : r * (q + 1) + (xcd - r) * q) + off; }
        const int nig = WGM * nN, gid = wgid / nig, fm = gid * WGM, gsz = (nM - fm) < WGM ? (nM - fm) : WGM;
        u.pm = fm + ((wgid % nig) % gsz); u.pn = (wgid % nig) / gsz; return true;
    }
    __device__ __forceinline__ void a_ready(const Unit&) const {}
    __device__ __forceinline__ void done(const Unit&) const {}
};

__device__ __forceinline__ unsigned cvt_pk_bf16(float lo, float hi) { unsigned r; asm volatile("v_cvt_pk_bf16_f32 %0, %1, %2" : "=v"(r) : "v"(lo), "v"(hi)); return r; }
__device__ __forceinline__ float silu_f(float v) { return v * __builtin_amdgcn_rcpf(1.0f + __expf(-v)); }

struct EpiSwiglu {
    static constexpr bool PERM = true, AFTER_DRAIN = false;
    bf16_t* O; int ldc;
    __device__ __forceinline__ void operator()(const f32x4 (&acc)[2][2][4][2], const Unit& u, int wr, int wc, int fr, int fq) const {
        const int row0 = u.pm * BM + wr * 64 + fr, col0 = u.pn * HALF + wc * 32 + 8 * fq;
#pragma unroll
        for (int ai = 0; ai < 2; ++ai)
#pragma unroll
            for (int m = 0; m < 4; ++m) { bf16_t* rowp = O + (size_t)(row0 + ai * HALF + m * 16) * ldc + col0;
                const f32x4 g0 = acc[ai][0][m][0], g1 = acc[ai][0][m][1], u0 = acc[ai][1][m][0], u1 = acc[ai][1][m][1];
                u32x4 w;
                w.x = cvt_pk_bf16(silu_f(g0[0]) * u0[0], silu_f(g0[1]) * u0[1]); w.y = cvt_pk_bf16(silu_f(g0[2]) * u0[2], silu_f(g0[3]) * u0[3]);
                w.z = cvt_pk_bf16(silu_f(g1[0]) * u1[0], silu_f(g1[1]) * u1[1]); w.w = cvt_pk_bf16(silu_f(g1[2]) * u1[2], silu_f(g1[3]) * u1[3]);
                *(u32x4*)rowp = w; }
    }
};
struct EpiBf16 {
    static constexpr bool PERM = true, AFTER_DRAIN = false;
    bf16_t* O; int ldc;
    __device__ __forceinline__ void operator()(const f32x4 (&acc)[2][2][4][2], const Unit& u, int wr, int wc, int fr, int fq) const {
        const int row0 = u.pm * BM + wr * 64 + fr, col0 = u.pn * BM + wc * 32 + 8 * fq;
#pragma unroll
        for (int ai = 0; ai < 2; ++ai)
#pragma unroll
            for (int m = 0; m < 4; ++m) { bf16_t* rowp = O + (size_t)(row0 + ai * HALF + m * 16) * ldc + col0;
#pragma unroll
                for (int bj = 0; bj < 2; ++bj) { const f32x4 v0 = acc[ai][bj][m][0], v1 = acc[ai][bj][m][1];
                    u32x4 w; w.x = cvt_pk_bf16(v0[0], v0[1]); w.y = cvt_pk_bf16(v0[2], v0[3]); w.z = cvt_pk_bf16(v1[0], v1[1]); w.w = cvt_pk_bf16(v1[2], v1[3]);
                    *(u32x4*)(rowp + bj * HALF) = w; } }
    }
};
struct EpiResid {
    static constexpr bool PERM = false, AFTER_DRAIN = false;
    const float* xin_ctx; const float* xin_lat; float* out; const float* gate; float scale;
    __device__ __forceinline__ void operator()(const f32x4 (&acc)[2][2][4][2], const Unit& u, int wr, int wc, int fr, int fq) const {
        const int row0 = u.pm * BM + wr * 64 + fr, col0 = u.pn * BM + wc * 32 + 4 * fq;
        const int cidx = u.pm < 32 ? 0 : 1 + ((u.pm - 32) >> 2);
        const float* xin = u.pm < 32 ? xin_ctx : xin_lat;
        const float* gp = gate + cidx * 9216 + col0;
        f32x4 gv[2][2];
#pragma unroll
        for (int bj = 0; bj < 2; ++bj)
#pragma unroll
            for (int n = 0; n < 2; ++n) gv[bj][n] = *(const f32x4*)(gp + bj * HALF + n * 16) * scale;
#pragma unroll
        for (int ai = 0; ai < 2; ++ai)
#pragma unroll
            for (int m = 0; m < 4; ++m) { const size_t off = (size_t)(row0 + ai * HALF + m * 16) * 1024 + col0;
#pragma unroll
                for (int bj = 0; bj < 2; ++bj)
#pragma unroll
                    for (int n = 0; n < 2; ++n) { const f32x4 xv = *(const f32x4*)(xin + off + bj * HALF + n * 16);
                        *(f32x4*)(out + off + bj * HALF + n * 16) = xv + gv[bj][n] * acc[ai][bj][m][n]; } }
    }
};

template <class Epi, class Sched, bool ALIGN_EPI = false, bool SP2 = false>
__device__ __forceinline__ void gemm_phase(PG8_LAS unsigned char* lds, const Gemm g, const Sched& S, const Epi& E, const int tid) {
    const int wid = __builtin_amdgcn_readfirstlane(tid >> 6), lane = tid & 63, wr = wid >> 2, wc = wid & 3, fr = lane & 15, fq = lane >> 4;
    const int K = g.K, nt = K / BK;
    unsigned voffA[2], voffB[2];
#pragma unroll
    for (int i = 0; i < 2; ++i) { int R, C; stage_rc(tid * 16 + i * 8192, R, C); const int Rb = Epi::PERM ? ((R & ~31) + perm32(R & 31)) : R;
        voffA[i] = (unsigned)(R * K + C) * 2u; voffB[i] = (unsigned)(Rb * K + C) * 2u; }
    const size_t kstep = (size_t)(BK * 2);
    const size_t hstep = (size_t)HALF * K * 2;
    const size_t tstep = 2 * hstep;
    const unsigned ldsw = (unsigned)wid * 1024u;
    const int aoff = lds_byte(wr * 64 + fr, fq * 8), boff = lds_byte(wc * 32 + fr, fq * 8);
#define PG8_SA(b, h) (((b) * 2 + (h)) * HTB)
#define PG8_SB(b, h) ((4 + (b) * 2 + (h)) * HTB)
#define PG8_STAGE(bufoff, gbase, voff) do { _Pragma("unroll") for (int _i = 0; _i < 2; ++_i) \
        __builtin_amdgcn_global_load_lds((const unsigned*)((const char*)(gbase) + (voff)[_i]), (PG8_LAS unsigned*)(lds + (bufoff) + ldsw + _i * 8192), 16, 0, 0); } while (0)
#define PG8_LDA(dst, b, h) do { _Pragma("unroll") for (int m = 0; m < 4; ++m) _Pragma("unroll") for (int k = 0; k < 2; ++k) dst[m][k] = *(const PG8_LAS bf16x8*)(lds + PG8_SA(b, h) + aoff + m * 2048 + k * 1024); } while (0)
#define PG8_LDB(dst, b, h) do { _Pragma("unroll") for (int n = 0; n < 2; ++n) _Pragma("unroll") for (int k = 0; k < 2; ++k) dst[n][k] = *(const PG8_LAS bf16x8*)(lds + PG8_SB(b, h) + boff + n * 2048 + k * 1024); } while (0)
#define PG8_MMA(ai, bj, At, Bt) do { __builtin_amdgcn_s_setprio(1); _Pragma("unroll") for (int m = 0; m < 4; ++m) _Pragma("unroll") for (int n = 0; n < 2; ++n) _Pragma("unroll") for (int k = 0; k < 2; ++k) \
        acc[ai][bj][m][n] = __builtin_amdgcn_mfma_f32_16x16x32_bf16(Bt[n][k], At[m][k], acc[ai][bj][m][n], 0, 0, 0); __builtin_amdgcn_s_setprio(0); } while (0)
#define PG8_WAIT_V(n) asm volatile("s_waitcnt vmcnt(" #n ")" ::: "memory")
#define PG8_WAIT_L(n) asm volatile("s_waitcnt lgkmcnt(" #n ")" ::: "memory")
#define PG8_BAR __builtin_amdgcn_s_barrier()
#define PG8_SCHED __builtin_amdgcn_sched_barrier(0)
    Unit cur, nxt; int ui = 0;
    if (!S.next(0, cur)) return;
    f32x4 acc[2][2][4][2];
#pragma unroll
    for (int a = 0; a < 2; ++a)
#pragma unroll
        for (int b = 0; b < 2; ++b)
#pragma unroll
            for (int m = 0; m < 4; ++m)
#pragma unroll
                for (int n = 0; n < 2; ++n) acc[a][b][m][n] = (f32x4){0.f, 0.f, 0.f, 0.f};
    bf16x8 At[4][2], B0[2][2], B1[2][2];
    const char* cA = (const char*)g.A + (size_t)cur.pm * tstep; const char* cB = (const char*)g.Bt + (size_t)cur.pn * tstep;
    S.a_ready(cur);
    if constexpr (SP2) {
        PG8_STAGE(PG8_SB(0, 0), cB, voffB); PG8_STAGE(PG8_SB(0, 1), cB + hstep, voffB); PG8_STAGE(PG8_SA(0, 0), cA, voffA); PG8_STAGE(PG8_SA(0, 1), cA + hstep, voffA);
        if (wr == 1) PG8_BAR;
        PG8_WAIT_V(2); PG8_BAR;
        PG8_STAGE(PG8_SB(1, 0), cB + kstep, voffB); PG8_STAGE(PG8_SA(1, 0), cA + kstep, voffA); PG8_STAGE(PG8_SB(1, 1), cB + hstep + kstep, voffB);
        PG8_WAIT_V(6); PG8_BAR;
    } else {
        PG8_STAGE(PG8_SB(0, 0), cB, voffB); PG8_STAGE(PG8_SA(0, 0), cA, voffA); PG8_STAGE(PG8_SB(0, 1), cB + hstep, voffB); PG8_STAGE(PG8_SA(0, 1), cA + hstep, voffA);
        if (wr == 1) PG8_BAR;
        PG8_WAIT_V(4); PG8_BAR;
        PG8_STAGE(PG8_SB(1, 0), cB + kstep, voffB); PG8_STAGE(PG8_SA(1, 0), cA + kstep, voffA); PG8_STAGE(PG8_SB(1, 1), cB + hstep + kstep, voffB);
        PG8_WAIT_V(6); PG8_BAR;
    }
    for (;;) {
        const bool has_next = S.next(ui + 1, nxt);
        const char* nA = has_next ? (const char*)g.A + (size_t)nxt.pm * tstep : cA; const char* nB = has_next ? (const char*)g.Bt + (size_t)nxt.pn * tstep : cB;
        for (int t = 0; t < nt; t += 2) {
            const bool last = (t == nt - 2);
            const char* a1 = cA + (size_t)(t + 1) * kstep;
            const char* a2 = last ? nA : cA + (size_t)(t + 2) * kstep; const char* b2 = last ? nB : cB + (size_t)(t + 2) * kstep;
            const char* a3 = a2 + kstep; const char* b3 = b2 + kstep;
            if (last && has_next) S.a_ready(nxt);
            if constexpr (SP2) {
            PG8_LDB(B0, 0, 0); PG8_LDB(B1, 0, 1); PG8_SCHED; PG8_LDA(At, 0, 0); PG8_STAGE(PG8_SA(1, 1), a1 + hstep, voffA);
            PG8_WAIT_V(8); PG8_WAIT_L(0); PG8_BAR; PG8_MMA(0, 0, At, B0); PG8_MMA(0, 1, At, B1); PG8_BAR; PG8_SCHED;
            PG8_LDA(At, 0, 1); PG8_STAGE(PG8_SB(0, 0), b2, voffB); PG8_STAGE(PG8_SB(0, 1), b2 + hstep, voffB); PG8_STAGE(PG8_SA(0, 0), a2, voffA);
            PG8_WAIT_V(8); PG8_WAIT_L(0); PG8_BAR; PG8_MMA(1, 0, At, B0); PG8_MMA(1, 1, At, B1); PG8_BAR; PG8_SCHED;
            PG8_LDB(B0, 1, 0); PG8_LDB(B1, 1, 1); PG8_SCHED; PG8_LDA(At, 1, 0); PG8_STAGE(PG8_SA(0, 1), a2 + hstep, voffA);
            PG8_WAIT_V(8); PG8_WAIT_L(0); PG8_BAR; PG8_MMA(0, 0, At, B0); PG8_MMA(0, 1, At, B1); PG8_BAR; PG8_SCHED;
            PG8_LDA(At, 1, 1); PG8_STAGE(PG8_SB(1, 0), b3, voffB); PG8_STAGE(PG8_SB(1, 1), b3 + hstep, voffB); PG8_STAGE(PG8_SA(1, 0), a3, voffA);
            PG8_WAIT_V(8); PG8_WAIT_L(0); PG8_BAR; PG8_MMA(1, 0, At, B0); PG8_MMA(1, 1, At, B1); PG8_BAR; PG8_SCHED;
            } else {
            PG8_LDB(B0, 0, 0); PG8_SCHED; PG8_LDA(At, 0, 0); PG8_STAGE(PG8_SA(1, 1), a1 + hstep, voffA);
            PG8_WAIT_L(8); PG8_BAR; PG8_WAIT_L(0); PG8_MMA(0, 0, At, B0); PG8_BAR; PG8_SCHED;
            PG8_LDB(B1, 0, 1); PG8_STAGE(PG8_SB(0, 0), b2, voffB);
            PG8_BAR; PG8_WAIT_L(0); PG8_MMA(0, 1, At, B1); PG8_BAR;
            PG8_LDA(At, 0, 1); PG8_STAGE(PG8_SA(0, 0), a2, voffA);
            PG8_BAR; PG8_WAIT_L(0); PG8_MMA(1, 0, At, B0); PG8_BAR; PG8_SCHED;
            PG8_STAGE(PG8_SB(0, 1), b2 + hstep, voffB);
            PG8_WAIT_V(6); PG8_BAR; PG8_MMA(1, 1, At, B1); PG8_BAR;
            PG8_LDB(B0, 1, 0); PG8_SCHED; PG8_LDA(At, 1, 0); PG8_STAGE(PG8_SA(0, 1), a2 + hstep, voffA);
            PG8_WAIT_L(8); PG8_BAR; PG8_WAIT_L(0); PG8_MMA(0, 0, At, B0); PG8_BAR; PG8_SCHED;
            PG8_LDB(B1, 1, 1); PG8_STAGE(PG8_SB(1, 0), b3, voffB);
            PG8_BAR; PG8_WAIT_L(0); PG8_MMA(0, 1, At, B1); PG8_BAR;
            PG8_LDA(At, 1, 1); PG8_STAGE(PG8_SA(1, 0), a3, voffA);
            PG8_BAR; PG8_WAIT_L(0); PG8_MMA(1, 0, At, B0); PG8_BAR; PG8_SCHED;
            PG8_STAGE(PG8_SB(1, 1), b3 + hstep, voffB);
            PG8_WAIT_V(6); PG8_BAR; PG8_MMA(1, 1, At, B1); PG8_BAR;
            }
        }
        if constexpr (ALIGN_EPI) { if (wr == 0) PG8_BAR; }
        if constexpr (!Epi::AFTER_DRAIN) { E(acc, cur, wr, wc, fr, fq); S.done(cur); }
        if (!has_next) break;
#pragma unroll
        for (int a = 0; a < 2; ++a)
#pragma unroll
            for (int b = 0; b < 2; ++b)
#pragma unroll
                for (int m = 0; m < 4; ++m)
#pragma unroll
                    for (int n = 0; n < 2; ++n) acc[a][b][m][n] = (f32x4){0.f, 0.f, 0.f, 0.f};
        cur = nxt; cA = nA; cB = nB; ++ui;
        if constexpr (ALIGN_EPI) { if (wr == 1) PG8_BAR; }
    }
    PG8_WAIT_V(0);
    if constexpr (!ALIGN_EPI) { if (wr == 0) PG8_BAR; }
    PG8_BAR;
#undef PG8_SA
#undef PG8_SB
#undef PG8_STAGE
#undef PG8_LDA
#undef PG8_LDB
#undef PG8_MMA
#undef PG8_WAIT_V
#undef PG8_WAIT_L
#undef PG8_BAR
#undef PG8_SCHED
}
}

constexpr int NTHR = 512, NWAVES = 8;
constexpr int D = 1024, TCTX = 8192, TLAT = 2048, TT = 10240, DFF = 2816;
constexpr int DIN = 3336, DINP = 3584;
constexpr int U_Z = 0, U_XBC = 256, U_DT = 1024, U_HY = 1032, U_RET = 1800, U_ATT = 2824;
constexpr float EPS = 1e-6f;
constexpr int NPHASE = 25;

constexpr size_t MiB = 1u << 20;
constexpr size_t WS_CTL = 0, CTL_ZERO_BYTES = 65536;
constexpr int CW_BAR = 4096;
constexpr size_t WS_MOD = 1 * MiB;
constexpr size_t WS_HK = 2 * MiB, HK_LAYER = 6 * MiB, HK1024_OFF = 1310720;
constexpr size_t WS_W = 14 * MiB, W_LAYER = 42 * MiB;
constexpr size_t W_IN0 = 0, W_IN1 = 11 * MiB, W_OUT0 = 22 * MiB, W_OUT1 = 22 * MiB + 5767168, W_MI = 33 * MiB, W_MO = 40 * MiB;
constexpr size_t WS_H = 98 * MiB;
constexpr size_t WS_YMIX = 118 * MiB;
constexpr size_t WS_UA = 138 * MiB;
constexpr size_t WS_XBC = 208 * MiB;
constexpr size_t WS_QK = 238 * MiB;
constexpr size_t WS_YS = 253 * MiB;
constexpr size_t WS_YR = 273 * MiB;
constexpr size_t WS_Z1 = 293 * MiB;
constexpr size_t WS_APC = 303 * MiB;
constexpr size_t WS_APL = 320 * MiB;
constexpr size_t WS_END = 335 * MiB;
constexpr size_t APC_ML = (size_t)8192 * 4 * 2 * 64 * 4, APL_ML = (size_t)2048 * 4 * 7 * 64 * 4;

constexpr size_t O_Y = 0, O_CK = 10485760, O_CV = 12582912, O_SSD = 14680064, O_RET = 18874368;

constexpr int LDS_BYTES = 147456;

struct Args { const float* in[35]; float* out; unsigned char* ws; int ph_lo, ph_hi; };
typedef const __attribute__((address_space(4))) unsigned char* kargp_t;
__device__ __forceinline__ unsigned long long karg_u64(int off) { asm volatile("" : "+s"(off)); kargp_t kp = (kargp_t)__builtin_amdgcn_kernarg_segment_ptr(); return *(const __attribute__((address_space(4))) unsigned long long*)(kp + off); }
__device__ __forceinline__ int karg_i32(int off) { asm volatile("" : "+s"(off)); kargp_t kp = (kargp_t)__builtin_amdgcn_kernarg_segment_ptr(); return *(const __attribute__((address_space(4))) int*)(kp + off); }
#define INP(i) ((const float*)karg_u64(8 * (i)))
#define AOUT() ((float*)karg_u64(8 * 35))
#define AWS() ((unsigned char*)karg_u64(8 * 36))


#define LDS_WAIT() asm volatile("s_waitcnt lgkmcnt(0)" ::: "memory")
__device__ __forceinline__ float bf2f(unsigned short b) { return __uint_as_float(((unsigned)b) << 16); }
__device__ __forceinline__ unsigned f2bf(float f) { unsigned u = __float_as_uint(f); return (u + 0x7fffu + ((u >> 16) & 1u)) >> 16; }
__device__ __forceinline__ unsigned pk2(float lo, float hi) { return f2bf(lo) | (f2bf(hi) << 16); }
__device__ __forceinline__ float wave_sum(float v) {
#pragma unroll
    for (int o = 1; o < 64; o <<= 1) v += __shfl_xor(v, o);
    return v;
}
__device__ __forceinline__ float siluf(float v) { return v / (1.0f + __expf(-v)); }
__device__ __forceinline__ void seq_info(int sq, int& L, int& base) { if (sq < 32) { L = 256; base = sq * 256; } else { L = 1024; base = TCTX + (sq - 32) * 1024; } }

__device__ __forceinline__ void transpose_item(const float* __restrict__ W, int K, int Nsrc, bf16* WT, int k0, int n0, int drow0, LAS float* scr, int lane) {
    const int nn = n0 + (lane & 31); const bool ok = nn < Nsrc;
#pragma unroll 8
    for (int i = 0; i < 32; ++i) { const int kk = 2 * i + (lane >> 5); scr[kk * 33 + (lane & 31)] = ok ? W[(size_t)(k0 + kk) * Nsrc + nn] : 0.f; }
    LDS_WAIT();
    const int c = lane & 7;
#pragma unroll
    for (int j = 0; j < 4; ++j) { const int n = (lane >> 3) + 8 * j; const LAS float* s = scr + (8 * c) * 33 + n;
        u32x4 o; o.x = pk2(s[0 * 33], s[1 * 33]); o.y = pk2(s[2 * 33], s[3 * 33]); o.z = pk2(s[4 * 33], s[5 * 33]); o.w = pk2(s[6 * 33], s[7 * 33]);
        *(u32x4*)(WT + (size_t)(drow0 + n) * K + k0 + 8 * c) = o; }
    LDS_WAIT();
}

__device__ __forceinline__ void phase0(unsigned char* lds, int tid, int lane, int wave, int G) {
    const int bid = blockIdx.x;
    float* fl = (float*)lds;
    {
        const float* cc = INP(6); const float* cctx = INP(7); const float* wmod = INP(8); const float* bmod = INP(9);
        float* mod = (float*)(AWS() + WS_MOD);
        float* sc = fl;
        float* red = fl + 3072;
        for (int i = tid; i < 3072; i += NTHR) { const int ci = i >> 10, k = i & 1023; const float v = ci == 0 ? cctx[k] : cc[(ci - 1) * 1024 + k]; sc[i] = siluf(v); }
        __syncthreads();
        for (int it = bid; it < 288; it += G) {
            const int l = it / 144, col = (it % 144) * 64 + lane;
            const float* wp = wmod + ((size_t)l * 1024 + wave * 128) * 9216 + col;
            float a0 = 0.f, a1 = 0.f, a2 = 0.f;
#pragma unroll 8
            for (int k = 0; k < 128; ++k) { const float w = wp[(size_t)k * 9216]; const int kk = wave * 128 + k; a0 += sc[kk] * w; a1 += sc[1024 + kk] * w; a2 += sc[2048 + kk] * w; }
            red[(wave * 3 + 0) * 64 + lane] = a0; red[(wave * 3 + 1) * 64 + lane] = a1; red[(wave * 3 + 2) * 64 + lane] = a2;
            __syncthreads();
            if (tid < 192) { const int ci = tid >> 6, ln = tid & 63; float s = bmod[l * 9216 + (it % 144) * 64 + ln];
#pragma unroll
                for (int w = 0; w < 8; ++w) s += red[(w * 3 + ci) * 64 + ln];
                mod[((size_t)l * 3 + ci) * 9216 + (it % 144) * 64 + ln] = s; }
            __syncthreads();
        }
    }
    __syncthreads();
    {
        float* feats = fl;
        float* h1 = fl + 512;
        float* h2 = fl + 1024;
        const float MIN_DECAY = -3.0701134573253945f, MAX_DECAY = -15.350567286626973f;
        for (int it = bid; it < 320; it += G) {
            const int l = it / 160, r = it % 160; const int L = r < 32 ? 256 : 1024; const int pg = r < 32 ? r : r - 32;
            const float* w1 = INP(23) + l * 33 * 64; const float* b1 = INP(24) + l * 64; const float* w2 = INP(25) + l * 64 * 64; const float* b2 = INP(26) + l * 64;
            const float* w3 = INP(27) + (size_t)l * 64 * 1024; const float* fr = INP(28) + l * 64; const float* hb = INP(29) + l * 512;
            float* Hk = (float*)(AWS() + WS_HK + (size_t)l * HK_LAYER + (L == 256 ? 0 : HK1024_OFF));
            if (tid < 8 * 33) { const int pl = tid / 33, j = tid % 33; const float pos = (float)(pg * 8 + pl); float f;
                if (j == 0) f = pos / (float)(L - 1);
                else { const int b = (j - 1) & 15; const float band = 1e-4f + (float)b * ((15.0f - 1e-4f) / 15.0f); const float ang = (6.283185307179586f / (float)L) * pos * band; f = j <= 16 ? cosf(ang) : -sinf(ang); }
                feats[pl * 36 + j] = f; }
            __syncthreads();
            { const int pl = tid >> 6, j = tid & 63; float s = b1[j];
                for (int k = 0; k < 33; ++k) s += feats[pl * 36 + k] * w1[k * 64 + j];
                h1[pl * 64 + j] = sinf(fr[j] * s); }
            __syncthreads();
            { const int pl = tid >> 6, j = tid & 63; float s = b2[j];
                for (int k = 0; k < 64; ++k) s += h1[pl * 64 + k] * w2[k * 64 + j];
                h2[pl * 64 + j] = sinf(fr[j] * s); }
            __syncthreads();
#pragma unroll
            for (int cc = 0; cc < 2; ++cc) {
                const int col = tid + cc * 512;
                float acc[8];
#pragma unroll
                for (int p = 0; p < 8; ++p) acc[p] = 0.f;
                for (int k = 0; k < 64; ++k) { const float w = w3[k * 1024 + col];
#pragma unroll
                    for (int p = 0; p < 8; ++p) acc[p] += h2[p * 64 + k] * w; }
                const int c = col & 255, o = (col >> 8) & 1, dir = col >> 9;
                const float delta = fabsf(MIN_DECAY + (float)c * ((MAX_DECAY - MIN_DECAY) / 255.0f));
                float* Ho = Hk + (size_t)o * (2 * L - 1) * 256 + c;
#pragma unroll
                for (int p = 0; p < 8; ++p) { const int pos = pg * 8 + p; const float t = (float)pos / (float)(L - 1);
                    float v = acc[p] * __expf(-t * delta);
                    if (dir == 0) { if (pos == 0) v += hb[o * 256 + c]; Ho[(size_t)(L - 1 + pos) * 256] = v; }
                    else if (pos > 0) Ho[(size_t)(L - 1 - pos) * 256] = v; }
            }
            __syncthreads();
        }
    }
    __syncthreads();
    {
        LAS float* scr = (LAS float*)((LAS unsigned char*)lds + wave * 16384);
        const int gw = bid * NWAVES + wave, NGW = G * NWAVES;
        constexpr int I_IN = 16 * 176, I_OUT = 44 * 32, I_MI = 16 * 112, I_MO = 16 * 32, I_LAYER = 2 * I_IN + 2 * I_OUT + I_MI + I_MO;
        for (int it = gw; it < 2 * I_LAYER; it += NGW) {
            const int l = it / I_LAYER; int r = it % I_LAYER;
            unsigned char* wl = AWS() + WS_W + (size_t)l * W_LAYER;
            if (r < 2 * I_IN) { const int f = r / I_IN; r %= I_IN; const int kb = r / 176, nb = r % 176, n0 = nb * 32;
                const int isup = n0 >= DFF, ff = isup ? n0 - DFF : n0; const int drow0 = (ff >> 7) * 256 + isup * 128 + (ff & 127);
                transpose_item(INP(11) + (size_t)(l * 2 + f) * 1024 * 5632, 1024, 5632, (bf16*)(wl + (f ? W_IN1 : W_IN0)), kb * 64, n0, drow0, scr, lane); continue; }
            r -= 2 * I_IN;
            if (r < 2 * I_OUT) { const int f = r / I_OUT; r %= I_OUT; const int kb = r / 32, nb = r % 32;
                transpose_item(INP(12) + (size_t)(l * 2 + f) * 2816 * 1024, 2816, 1024, (bf16*)(wl + (f ? W_OUT1 : W_OUT0)), kb * 64, nb * 32, nb * 32, scr, lane); continue; }
            r -= 2 * I_OUT;
            if (r < I_MI) { const int kb = r / 112, nb = r % 112;
                transpose_item(INP(13) + (size_t)l * 1024 * DIN, 1024, DIN, (bf16*)(wl + W_MI), kb * 64, nb * 32, nb * 32, scr, lane); continue; }
            r -= I_MI;
            { const int kb = r / 32, nb = r % 32;
                transpose_item(INP(14) + (size_t)l * 1024 * 1024, 1024, 1024, (bf16*)(wl + W_MO), kb * 64, nb * 32, nb * 32, scr, lane); }
        }
    }
}

__device__ __forceinline__ void prep_phase(const float* xc, const float* xl, const float* nw, const float* modl, int p, bf16* H, int gw, int NGW, int lane) {
    f32x4 wv[4];
#pragma unroll
    for (int j = 0; j < 4; ++j) wv[j] = *(const f32x4*)(nw + 4 * lane + 256 * j);
    for (int row = gw; row < TT; row += NGW) {
        const float* x = (row < TCTX ? xc : xl) + (size_t)row * D;
        const int cidx = row < TCTX ? 0 : 1 + ((row - TCTX) >> 10);
        const float* sh = modl + (size_t)cidx * 9216 + (3 * p) * 1024; const float* sc = sh + 1024;
        f32x4 v[4]; float ss = 0.f;
#pragma unroll
        for (int j = 0; j < 4; ++j) { v[j] = *(const f32x4*)(x + 4 * lane + 256 * j); ss += (v[j].x * v[j].x + v[j].y * v[j].y) + (v[j].z * v[j].z + v[j].w * v[j].w); }
        const float rstd = rsqrtf(wave_sum(ss) * (1.0f / D) + EPS);
#pragma unroll
        for (int j = 0; j < 4; ++j) { const f32x4 s1 = *(const f32x4*)(sc + 4 * lane + 256 * j), s0 = *(const f32x4*)(sh + 4 * lane + 256 * j);
            const f32x4 y = (v[j] * rstd * wv[j]) * (s1 + 1.0f) + s0;
            u32x2 o; o.x = pk2(y.x, y.y); o.y = pk2(y.z, y.w);
            *(u32x2*)(H + (size_t)row * D + 4 * lane + 256 * j) = o; }
    }
}

__device__ __forceinline__ void m1_phase(int li, int gw, int NGW, int lane) {
    const bf16* U = (const bf16*)(AWS() + WS_UA);
    float* XBC = (float*)(AWS() + WS_XBC); float* QK = (float*)(AWS() + WS_QK);
    const float* cw = INP(15) + li * 3 * 768; const float* cb = INP(16) + li * 768;
    const float* qw = INP(32) + li * 64; const float* kw = INP(33) + li * 64;
    const float qwl = qw[lane], kwl = kw[lane];
    const int hf = lane >> 5, ri = lane & 31, fi = ri & 15;
    const float inv = exp2f(-(float)fi * (13.287712379549449f / 16.0f));
    for (int tok = gw; tok < TT; tok += NGW) {
        int sq, pos, L;
        if (tok < TCTX) { sq = tok >> 8; pos = tok & 255; L = 256; } else { sq = 32 + ((tok - TCTX) >> 10); pos = (tok - TCTX) & 1023; L = 1024; }
        const bf16* ur = U + (size_t)tok * DINP;
#pragma unroll
        for (int i = 0; i < 12; ++i) { const int ch = lane + 64 * i;
            const float c0 = bf2f(ur[U_XBC + ch]);
            const float cm = pos > 0 ? bf2f(ur[U_XBC + ch - DINP]) : 0.f;
            const float cp = pos < L - 1 ? bf2f(ur[U_XBC + ch + DINP]) : 0.f;
            const float v = cb[ch] + cw[ch] * cm + cw[768 + ch] * c0 + cw[1536 + ch] * cp;
            XBC[(size_t)tok * 768 + ch] = siluf(v); }
        float sn = 0.f, cs = 1.f;
        if (sq >= 32) { const float pv = hf ? (float)(pos & 63) : (float)(pos >> 6); sincosf(pv * inv, &sn, &cs); }
#pragma unroll
        for (int h = 0; h < 6; ++h) {
            const float x = bf2f(ur[U_ATT + h * 64 + lane]);
            const float ss = wave_sum(x * x);
            float y = x * rsqrtf(ss * (1.0f / 64.0f) + EPS) * (h < 4 ? qwl : kwl);
            if (h >= 4 && sq < 32) AOUT()[O_CK + ((((size_t)sq * 2 + li) * 256 + pos) * 2 + (h - 4)) * 64 + lane] = y;
            if (sq >= 32) { const float yp = __shfl_xor(y, 16); y = (ri < 16) ? y * cs - yp * sn : yp * sn + y * cs; }
            QK[(size_t)tok * 384 + h * 64 + lane] = y;
        }
        if (sq < 32) {
#pragma unroll
            for (int kv = 0; kv < 2; ++kv) AOUT()[O_CV + ((((size_t)sq * 2 + li) * 256 + pos) * 2 + kv) * 64 + lane] = bf2f(ur[U_ATT + 384 + kv * 64 + lane]);
        }
    }
}

template <int N, bool SSD>
__device__ __forceinline__ void scan_item(int li, int sq, int h, int dir, unsigned char* lds, int tid, int lane, int wave) {
    constexpr int TC = 32, G = (2 * N + 64) / 4, R = (TC * G) / NTHR, NPL = N / 8;
    constexpr int CHF = TC * (2 * N + 64) + 64;
    static_assert((TC * G) % NTHR == 0, "chunk loader");
    int L, base; seq_info(sq, L, base);
    float* buf = (float*)lds;
    const float* XBC = (const float*)(AWS() + WS_XBC); const bf16* U = (const bf16*)(AWS() + WS_UA);
    float* Y = (float*)(AWS() + (SSD ? WS_YS : WS_YR)) + (size_t)dir * TT * 256;
    const int g = h >> 1;
    float pA = 0.f, pK = 0.f;
    float dtb = 0.f, aneg = 0.f;
    if (SSD) { dtb = INP(17)[(li * 2 + dir) * 4 + h]; aneg = -__expf(INP(18)[(li * 2 + dir) * 4 + h]); }
    else { const float dl = INP(30)[(li * 2 + dir) * 4 + h]; pA = 1.0f / (1.0f + __expf(-dl)); pK = 0.125f; }
    f32x4 pre[R];
    const int nch = L / TC;
    auto issue = [&](int ch) {
#pragma unroll
        for (int r = 0; r < R; ++r) { const int gi0 = tid + NTHR * r, j = gi0 / G, gi = gi0 % G; const int s = ch * TC + j, pos = dir ? L - 1 - s : s; const size_t tok = (size_t)base + pos;
            if (SSD) { const int col = gi < N / 4 ? 512 + g * 128 + 4 * gi : (gi < N / 2 ? 256 + g * 128 + 4 * (gi - N / 4) : h * 64 + 4 * (gi - N / 2));
                pre[r] = *(const f32x4*)(XBC + tok * 768 + col); }
            else { const int col = U_RET + (gi < N / 4 ? h * 64 + 4 * gi : (gi < N / 2 ? 256 + h * 64 + 4 * (gi - N / 4) : 512 + h * 64 + 4 * (gi - N / 2)));
                const u16x4 w = *(const u16x4*)(U + tok * DINP + col); pre[r] = (f32x4){bf2f(w.x), bf2f(w.y), bf2f(w.z), bf2f(w.w)}; } }
        if (SSD && tid < TC) { const int s = ch * TC + tid, pos = dir ? L - 1 - s : s; const float x = bf2f(U[((size_t)base + pos) * DINP + U_DT + dir * 4 + h]) + dtb;
            const float dt = x > 20.f ? x : log1pf(__expf(x)); pK = dt; pA = __expf(dt * aneg); }
    };
    auto commit = [&](int bsel) {
        float* b = buf + bsel * CHF;
#pragma unroll
        for (int r = 0; r < R; ++r) { const int gi0 = tid + NTHR * r, j = gi0 / G, gi = gi0 % G;
            const int off = gi < N / 4 ? j * N + 4 * gi : (gi < N / 2 ? TC * N + j * N + 4 * (gi - N / 4) : 2 * TC * N + j * 64 + 4 * (gi - N / 2));
            *(f32x4*)(b + off) = pre[r]; }
        if (tid < TC) { b[TC * (2 * N + 64) + tid] = pA; b[TC * (2 * N + 64) + 32 + tid] = pK; }
    };
    const int pl = lane >> 3, ns = lane & 7, p = wave * 8 + pl;
    float S[NPL];
    if (sq < 32) {
#pragma unroll
        for (int i = 0; i < NPL; ++i) S[i] = 0.f;
    } else {
        const float* s0 = INP(SSD ? 4 : 5) + ((((size_t)(sq - 32) * 2 + li) * 2 + dir) * 4 + h) * (size_t)(N * 64);
#pragma unroll
        for (int i = 0; i < NPL; ++i) S[i] = s0[(ns * NPL + i) * 64 + p];
    }
    issue(0);
    __syncthreads();
    commit(0);
    __syncthreads();
    for (int ch = 0; ch < nch; ++ch) {
        if (ch + 1 < nch) issue(ch + 1);
        const float* b = buf + (ch & 1) * CHF;
        const float* Qs = b, *Ks = b + TC * N, *Vs = b + 2 * TC * N, *As = b + TC * (2 * N + 64), *KSs = As + 32;
        for (int j = 0; j < TC; ++j) {
            const float av = As[j], kv = KSs[j] * Vs[j * 64 + p];
            float y = 0.f;
#pragma unroll
            for (int i4 = 0; i4 < NPL / 4; ++i4) { const f32x4 k4 = *(const f32x4*)(Ks + j * N + ns * NPL + 4 * i4), q4 = *(const f32x4*)(Qs + j * N + ns * NPL + 4 * i4);
#pragma unroll
                for (int e = 0; e < 4; ++e) { S[4 * i4 + e] = av * S[4 * i4 + e] + k4[e] * kv; y += q4[e] * S[4 * i4 + e]; } }
            y += __shfl_xor(y, 1); y += __shfl_xor(y, 2); y += __shfl_xor(y, 4);
            if (ns == 0) { const int s = ch * TC + j, pos = dir ? L - 1 - s : s; Y[((size_t)base + pos) * 256 + h * 64 + p] = y; }
        }
        if (ch + 1 < nch) commit((ch + 1) & 1);
        __syncthreads();
    }
    if (sq < 32) {
        float* so = AOUT() + (SSD ? O_SSD : O_RET) + ((((size_t)sq * 2 + li) * 2 + dir) * 4 + h) * (size_t)(N * 64);
#pragma unroll
        for (int i = 0; i < NPL; ++i) so[(ns * NPL + i) * 64 + p] = S[i];
    }
}

__device__ __forceinline__ void attn_item(int li, int sq, int kvh, int qb, int kt, unsigned char* lds, int tid, int lane, int wave) {
    int L, base; seq_info(sq, L, base);
    const bool lat = sq >= 32;
    const float* QK = (const float*)(AWS() + WS_QK); const bf16* U = (const bf16*)(AWS() + WS_UA);
    float* Ks = (float*)lds; float* Vs = Ks + 128 * 64;
    const int kb = qb + kt - 5;
    __syncthreads();
#pragma unroll
    for (int r = 0; r < 4; ++r) { const int e = tid + NTHR * r, j = e >> 4, c4 = (e & 15) * 4;
        f32x4 kq, vq;
        if (lat && kt < 4) { const size_t ci = ((((size_t)(sq - 32) * 2 + li) * 512 + kt * 128 + j) * 2 + kvh) * 64 + c4; kq = *(const f32x4*)(INP(2) + ci); vq = *(const f32x4*)(INP(3) + ci); }
        else { const size_t tok = (size_t)base + (lat ? kb : kt) * 128 + j; kq = *(const f32x4*)(QK + tok * 384 + 256 + kvh * 64 + c4);
            const u16x4 w = *(const u16x4*)(U + tok * DINP + U_ATT + 384 + kvh * 64 + c4); vq = (f32x4){bf2f(w.x), bf2f(w.y), bf2f(w.z), bf2f(w.w)}; }
        *(f32x4*)(Ks + j * 64 + c4) = kq; *(f32x4*)(Vs + j * 64 + c4) = vq; }
    const int pair = tid & 255, khalf = tid >> 8, qi = pair & 127, hh = pair >> 7, head = kvh * 2 + hh;
    const size_t qtok = (size_t)base + qb * 128 + qi;
    f32x4 q[16], o[16];
#pragma unroll
    for (int i = 0; i < 16; ++i) { q[i] = *(const f32x4*)(QK + qtok * 384 + head * 64 + 4 * i) * 0.125f; o[i] = (f32x4){0.f, 0.f, 0.f, 0.f}; }
    float m = -1e30f, l = 0.f;
    __syncthreads();
    const bool masked = lat && kt >= 4;
    const int qpos = qb * 128 + qi;
    for (int jj = 0; jj < 64; ++jj) {
        const int j = khalf * 64 + jj;
        f32x4 sa = (f32x4){0.f, 0.f, 0.f, 0.f};
#pragma unroll
        for (int i = 0; i < 16; ++i) sa += q[i] * *(const f32x4*)(Ks + j * 64 + 4 * i);
        const float s = (sa.x + sa.y) + (sa.z + sa.w);
        bool valid = true;
        if (masked) { const int d = qpos - (kb * 128 + j); valid = (d <= 128) && (d >= -128); }
        if (valid) {
            if (s > m) { const float corr = __expf(m - s); l *= corr;
#pragma unroll
                for (int i = 0; i < 16; ++i) o[i] *= corr;
                m = s; }
            const float pexp = __expf(s - m); l += pexp;
#pragma unroll
            for (int i = 0; i < 16; ++i) o[i] += pexp * *(const f32x4*)(Vs + j * 64 + 4 * i);
        }
    }
    __syncthreads();
    float* mg = (float*)lds + pair * 68;
    if (khalf == 1) { mg[0] = m; mg[1] = l;
#pragma unroll
        for (int i = 0; i < 16; ++i) *(f32x4*)(mg + 4 + 4 * i) = o[i]; }
    __syncthreads();
    if (khalf == 0) { const float m1 = mg[0], l1 = mg[1]; const float M = fmaxf(m, m1), c0 = __expf(m - M), c1 = __expf(m1 - M);
        mg[0] = M; mg[1] = l * c0 + l1 * c1;
#pragma unroll
        for (int i = 0; i < 16; ++i) { const f32x4 o1 = *(const f32x4*)(mg + 4 + 4 * i); *(f32x4*)(mg + 4 + 4 * i) = o[i] * c0 + o1 * c1; } }
    __syncthreads();
    float* OP = (float*)(AWS() + (lat ? WS_APL : WS_APC)); float* MLp = (float*)(AWS() + (lat ? WS_APL + APL_ML : WS_APC + APC_ML));
    const int NS = lat ? 7 : 2; const size_t tb = lat ? (size_t)(base - TCTX) : (size_t)base;
    for (int pr = wave * 32; pr < wave * 32 + 32; ++pr) { const int qq = pr & 127, hd = kvh * 2 + (pr >> 7);
        const size_t idx = ((tb + qb * 128 + qq) * 4 + hd) * NS + kt; const float* src = (const float*)lds + pr * 68;
        OP[idx * 64 + lane] = src[4 + lane];
        if (lane < 2) MLp[idx * 2 + lane] = src[lane]; }
}

template <int ORDER>
__device__ __forceinline__ void hyena_item(int li, int sq, int cgp, int tt, int lane) {
    int L, base; seq_info(sq, L, base);
    const int c = cgp * 64 + lane, t0 = tt * 16;
    const float* Hk = (const float*)(AWS() + WS_HK + (size_t)li * HK_LAYER + (L == 256 ? 0 : HK1024_OFF)) + (size_t)ORDER * (2 * L - 1) * 256 + c;
    const bf16* U = (const bf16*)(AWS() + WS_UA); const float* Z1 = (const float*)(AWS() + WS_Z1);
    const float* cw = INP(21) + li * 3 * 768; const float* cb = INP(22) + li * 768;
    const float w0 = cw[c], w1 = cw[768 + c], w2 = cw[1536 + c], b0 = cb[c];
    float acc[16];
#pragma unroll
    for (int i = 0; i < 16; ++i) acc[i] = 0.f;
    for (int s0 = 0; s0 < L; s0 += 16) {
        float W[31], z[16];
        const int l0 = t0 - s0 + L - 1 - 15;
#pragma unroll
        for (int m = 0; m < 31; ++m) W[m] = Hk[(size_t)(l0 + m) * 256];
        if (ORDER == 0) {
            float ur[18];
#pragma unroll
            for (int i = 0; i < 18; ++i) { const int s = s0 - 1 + i; ur[i] = (s >= 0 && s < L) ? bf2f(U[((size_t)base + s) * DINP + U_HY + c]) : 0.f; }
#pragma unroll
            for (int j = 0; j < 16; ++j) z[j] = b0 + w0 * ur[j] + w1 * ur[j + 1] + w2 * ur[j + 2];
        } else {
#pragma unroll
            for (int j = 0; j < 16; ++j) z[j] = Z1[((size_t)base + s0 + j) * 256 + c];
        }
#pragma unroll
        for (int j = 0; j < 16; ++j)
#pragma unroll
            for (int i = 0; i < 16; ++i) acc[i] += W[15 - j + i] * z[j];
    }
    const int cx = 256 * (ORDER + 1) + c;
    const float v0 = cw[cx], v1 = cw[768 + cx], v2 = cw[1536 + cx], vb = cb[cx];
    float ur[18];
#pragma unroll
    for (int i = 0; i < 18; ++i) { const int s = t0 - 1 + i; ur[i] = (s >= 0 && s < L) ? bf2f(U[((size_t)base + s) * DINP + U_HY + cx]) : 0.f; }
#pragma unroll
    for (int i = 0; i < 16; ++i) { const float xm = vb + v0 * ur[i] + v1 * ur[i + 1] + v2 * ur[i + 2]; const float r = xm * acc[i];
        if (ORDER == 0) ((float*)(AWS() + WS_Z1))[((size_t)base + t0 + i) * 256 + c] = r;
        else ((bf16*)(AWS() + WS_YMIX))[((size_t)base + t0 + i) * D + 256 + c] = (bf16)f2bf(r); }
}

__device__ __forceinline__ void finalize_token(int li, int tok, int lane) {
    const bf16* ur = (const bf16*)(AWS() + WS_UA) + (size_t)tok * DINP;
    bf16* ym = (bf16*)(AWS() + WS_YMIX) + (size_t)tok * D;
    const float* YS = (const float*)(AWS() + WS_YS); const float* YR = (const float*)(AWS() + WS_YR); const float* XBC = (const float*)(AWS() + WS_XBC);
    const int ch0 = lane * 4, hd = lane >> 4;
    {
        const f32x4 yf = *(const f32x4*)(YS + (size_t)tok * 256 + ch0), yb = *(const f32x4*)(YS + ((size_t)TT + tok) * 256 + ch0), xs = *(const f32x4*)(XBC + (size_t)tok * 768 + ch0);
        const u16x4 zw = *(const u16x4*)(ur + U_Z + ch0);
        const float dsk = INP(19)[li * 4 + hd];
        f32x4 y = yf + yb + xs * dsk;
        y.x *= siluf(bf2f(zw.x)); y.y *= siluf(bf2f(zw.y)); y.z *= siluf(bf2f(zw.z)); y.w *= siluf(bf2f(zw.w));
        const float ss = wave_sum((y.x * y.x + y.y * y.y) + (y.z * y.z + y.w * y.w));
        const float rstd = rsqrtf(ss * (1.0f / 256.0f) + EPS);
        const f32x4 nw = *(const f32x4*)(INP(20) + li * 256 + ch0);
        y = y * rstd * nw;
        u32x2 o; o.x = pk2(y.x, y.y); o.y = pk2(y.z, y.w); *(u32x2*)(ym + ch0) = o;
    }
    {
        const f32x4 yf = *(const f32x4*)(YR + (size_t)tok * 256 + ch0), yb = *(const f32x4*)(YR + ((size_t)TT + tok) * 256 + ch0);
        f32x4 y = yf + yb;
        float s = (y.x + y.y) + (y.z + y.w);
        s += __shfl_xor(s, 1); s += __shfl_xor(s, 2); s += __shfl_xor(s, 4); s += __shfl_xor(s, 8);
        const float mu = s * (1.0f / 64.0f);
        y = y - mu;
        float q = (y.x * y.x + y.y * y.y) + (y.z * y.z + y.w * y.w);
        q += __shfl_xor(q, 1); q += __shfl_xor(q, 2); q += __shfl_xor(q, 4); q += __shfl_xor(q, 8);
        const float rstd = rsqrtf(q * (1.0f / 64.0f) + EPS);
        const f32x4 gw = *(const f32x4*)(INP(31) + li * 256 + ch0);
        const u16x4 gg = *(const u16x4*)(ur + U_RET + 768 + ch0);
        y = y * rstd * gw;
        y.x *= siluf(bf2f(gg.x)); y.y *= siluf(bf2f(gg.y)); y.z *= siluf(bf2f(gg.z)); y.w *= siluf(bf2f(gg.w));
        u32x2 o; o.x = pk2(y.x, y.y); o.y = pk2(y.z, y.w); *(u32x2*)(ym + 512 + ch0) = o;
    }
    {
        const bool lat = tok >= TCTX;
        const float* OP = (const float*)(AWS() + (lat ? WS_APL : WS_APC)); const float* MLp = (const float*)(AWS() + (lat ? WS_APL + APL_ML : WS_APC + APC_ML));
        const int NS = lat ? 7 : 2; const size_t tb = lat ? (size_t)(tok - TCTX) : (size_t)tok;
        const int qb = lat ? (((tok - TCTX) & 1023) >> 7) : 0;
#pragma unroll
        for (int h = 0; h < 4; ++h) {
            const size_t idx = (tb * 4 + h) * NS;
            float ms = -1e30f, ls = 0.f;
            const bool sv = lane < NS && !(lat && ((lane == 4 && qb == 0) || (lane == 6 && qb == 7)));
            if (sv) { const f32x2 t = *(const f32x2*)(MLp + (idx + lane) * 2); ms = t.x; ls = t.y; }
            const float sink = INP(34)[li * 4 + h];
            float M = ms;
#pragma unroll
            for (int o = 1; o < 8; o <<= 1) M = fmaxf(M, __shfl_xor(M, o));
            M = fmaxf(M, sink);
            const float w = sv ? __expf(ms - M) : 0.f;
            float den = w * ls;
#pragma unroll
            for (int o = 1; o < 8; o <<= 1) den += __shfl_xor(den, o);
            den += __expf(sink - M);
            den = __shfl(den, 0);
            float ov = 0.f;
            for (int s = 0; s < NS; ++s) { const float ws_ = __shfl(w, s); if (ws_ != 0.f) ov += ws_ * OP[(idx + s) * 64 + lane]; }
            ym[768 + h * 64 + lane] = (bf16)f2bf(ov / den);
        }
    }
}


#define XB_TMO      128
#define XB_XCNT(j)  (256  + 64 * (j))
#define XB_XSUB(j)  (1280 + 64 * (j))
#define XB_XGEN(j)  (2304 + 64 * (j))
#define XB_TOP      3328
#define XB_TOPGEN   3392
#define XCD_BAR_WORDS 3456
#define XB_SPIN_CAP (1u << 18)
__device__ __forceinline__ unsigned xb_ld(unsigned* p)              { return __hip_atomic_load(p, __ATOMIC_RELAXED, __HIP_MEMORY_SCOPE_AGENT); }
__device__ __forceinline__ unsigned xb_add(unsigned* p, unsigned v) { return __hip_atomic_fetch_add(p, v, __ATOMIC_RELAXED, __HIP_MEMORY_SCOPE_AGENT); }
__device__ __forceinline__ unsigned xb_xcc_id() { return (unsigned)__builtin_amdgcn_s_getreg((3 << 11) | 20) & 0xFu; }
#define XB_SPIN(cond, bar) do { unsigned _sp = 0; while (cond) { __builtin_amdgcn_s_sleep(1); \
    if ((++_sp & 255u) == 0u) { if (xb_ld(&(bar)[XB_TMO])) break; if (_sp > XB_SPIN_CAP) { atomicAdd(&(bar)[XB_TMO], 1u); break; } } } } while (0)
__device__ __forceinline__ void xcd_barrier_complete(unsigned* bar, unsigned x, unsigned& nloc, unsigned& nx) {
    const unsigned G = gridDim.x * gridDim.y * gridDim.z;
    unsigned sum, cnt, mine, sp = 0u;
    for (;;) {
        sum = 0u; cnt = 0u; mine = 0u;
#pragma unroll
        for (unsigned j = 0; j < 16; ++j) { const unsigned c = xb_ld(&bar[XB_XCNT(j)]); sum += c; cnt += (c > 0u) ? 1u : 0u; mine = (j == x) ? c : mine; }
        if (sum == G) break;
        __builtin_amdgcn_s_sleep(1);
        if ((++sp & 255u) == 0u) { if (xb_ld(&bar[XB_TMO])) break; if (sp > XB_SPIN_CAP) { atomicAdd(&bar[XB_TMO], 1u); break; } }
    }
    nloc = mine > 0u ? mine : 1u; nx = cnt > 0u ? cnt : 1u;
}
__device__ __forceinline__ void xcd_barrier(unsigned* bar, volatile LAS unsigned* st) {
    asm volatile("s_waitcnt vmcnt(0)" ::: "memory");
    __syncthreads();
    if (threadIdx.x == 0) {
        const unsigned x = xb_xcc_id();
        __builtin_amdgcn_s_waitcnt(0);
        unsigned nloc = st[0], nx = st[1];
        if (nloc == 0u) { xcd_barrier_complete(bar, x, nloc, nx); st[0] = nloc; st[1] = nx; }
        const unsigned old = xb_add(&bar[XB_XSUB(x)], 1u);
        const unsigned gen = old / nloc;
        if (old + 1u == (gen + 1u) * nloc) {
            __builtin_amdgcn_fence(__ATOMIC_RELEASE, "agent");
            asm volatile("s_waitcnt vmcnt(0)" ::: "memory");
            const unsigned og = xb_add(&bar[XB_TOP], 1u);
            const unsigned tg = og / nx;
            if (og + 1u == (tg + 1u) * nx) xb_add(&bar[XB_TOPGEN], 1u);
            else XB_SPIN(xb_ld(&bar[XB_TOPGEN]) == tg, bar);
            __builtin_amdgcn_fence(__ATOMIC_ACQUIRE, "agent");
            xb_add(&bar[XB_XGEN(x)], 1u);
            asm volatile("s_waitcnt vmcnt(0)" ::: "memory");
        } else {
            XB_SPIN(xb_ld(&bar[XB_XGEN(x)]) == gen, bar);
            __builtin_amdgcn_fence(__ATOMIC_ACQUIRE, "agent");
            asm volatile("s_waitcnt vmcnt(0)" ::: "memory");
        }
    }
    __syncthreads();
}

__device__ __forceinline__ int dq_next(unsigned* ctr, volatile int* slot, int tid) {
    __syncthreads();
    if (tid == 0) *slot = (int)__hip_atomic_fetch_add(ctr, 1u, __ATOMIC_RELAXED, __HIP_MEMORY_SCOPE_AGENT);
    __syncthreads();
    return *slot;
}

__global__ void __launch_bounds__(NTHR, 2) mk_fwd(Args a) {
    extern __shared__ __attribute__((aligned(16))) unsigned char lds[];
    const int ph_hi = karg_i32(8 * 37 + 4);
    if (threadIdx.x < 64) ((volatile LAS unsigned*)((LAS unsigned char*)lds + 131072))[threadIdx.x] = 0u;
    __syncthreads();
    if (!MK_MULTI && threadIdx.x == 0) (void)xb_add((unsigned*)(AWS() + WS_CTL) + CW_BAR + XB_XCNT(xb_xcc_id()), 1u);
    for (int ph = karg_i32(8 * 37); ph < ph_hi; ++ph) {
        int tid = threadIdx.x; asm volatile("" : "+v"(tid));
        int G = gridDim.x, bid = blockIdx.x; asm volatile("" : "+s"(G), "+s"(bid));
        const int lane = tid & 63, wave = __builtin_amdgcn_readfirstlane(tid >> 6);
        const int gw = bid * NWAVES + wave, NGW = G * NWAVES;
        unsigned* ctl = (unsigned*)(AWS() + WS_CTL);
        volatile int* qslot = (volatile int*)(lds + 131072 + 64);
        float* xbuf = AOUT() + O_Y;
        if (ph == 0) {
            if (EN(0)) phase0(lds, tid, lane, wave, G);
        } else if (ph == NPHASE) {
            float* o = AOUT();
#define ZERO_OUT(i, lo, hi) if (!((MK_KEEP >> (i)) & 1)) for (size_t e = (size_t)(lo) + (size_t)bid * NTHR + tid; e < (size_t)(hi); e += (size_t)G * NTHR) o[e] = 0.f;
            ZERO_OUT(0, 0, 8388608) ZERO_OUT(1, 8388608, 10485760) ZERO_OUT(2, 10485760, 12582912) ZERO_OUT(3, 12582912, 14680064) ZERO_OUT(4, 14680064, 18874368) ZERO_OUT(5, 18874368, 20971520)
        } else {
            const int li = (ph - 1) / 12, k = (ph - 1) % 12;
            const float* modl = (const float*)(AWS() + WS_MOD) + (size_t)li * 3 * 9216;
            unsigned char* wl = AWS() + WS_W + (size_t)li * W_LAYER;
            const bool first = (li == 0 && k <= 2);
            const float* xc = first ? INP(0) : xbuf;
            const float* xl = first ? INP(1) - (size_t)TCTX * D : xbuf;
            if (k == 0 || k == 3 || k == 9) {
                const int p = k == 0 ? 0 : (k == 3 ? 1 : 2);
                if (EN(1)) prep_phase(xc, xl, INP(10) + (li * 3 + p) * 1024, modl, p, (bf16*)(AWS() + WS_H), gw, NGW, lane);
            } else if (k == 1 || k == 10) {
                pg8::Gemm g{(const bf16*)(AWS() + WS_H), (const bf16*)(wl + (k == 1 ? W_IN0 : W_IN1)), TT, 2 * DFF, D};
                pg8::StaticOrder S; S.init(TT, 2 * DFF, G, bid);
                pg8::EpiSwiglu E{(bf16*)(AWS() + WS_UA), DFF};
                if (EN(2)) pg8::gemm_phase<pg8::EpiSwiglu, pg8::StaticOrder, true, true>((LAS unsigned char*)lds, g, S, E, tid);
            } else if (k == 2 || k == 8 || k == 11) {
                const bool mix = (k == 8);
                pg8::Gemm g{(const bf16*)(AWS() + (mix ? WS_YMIX : WS_UA)), (const bf16*)(wl + (mix ? W_MO : (k == 2 ? W_OUT0 : W_OUT1))), TT, D, mix ? D : DFF};
                pg8::StaticOrder S; S.init(TT, D, G, bid);
                const int gi = k == 2 ? 2 : (k == 8 ? 5 : 8);
                pg8::EpiResid E{xc, xl, xbuf, modl + gi * 1024, mix ? 1.0f : 0.5f};
                if (EN(3)) pg8::gemm_phase<pg8::EpiResid, pg8::StaticOrder, true, true>((LAS unsigned char*)lds, g, S, E, tid);
            } else if (k == 4) {
                pg8::Gemm g{(const bf16*)(AWS() + WS_H), (const bf16*)(wl + W_MI), TT, DINP, D};
                pg8::StaticOrder S; S.init(TT, DINP, G, bid);
                pg8::EpiBf16 E{(bf16*)(AWS() + WS_UA), DINP};
                if (EN(4)) pg8::gemm_phase<pg8::EpiBf16, pg8::StaticOrder, true, true>((LAS unsigned char*)lds, g, S, E, tid);
            } else if (k == 5) {
                if (EN(5)) m1_phase(li, gw, NGW, lane);
            } else if (k == 6) {
                for (;;) {
                    int it = dq_next(ctl + ph, qslot, threadIdx.x);
                    if (it >= 1344) break;
                    int tid = threadIdx.x, li = (ph - 1) / 12; asm volatile("" : "+v"(tid)); asm volatile("" : "+s"(li));
                    const int lane = tid & 63, wave = __builtin_amdgcn_readfirstlane(tid >> 6);
                    if (it < 16) { if (EN(6)) scan_item<128, true>(li, 32 + (it >> 3), (it >> 1) & 3, it & 1, lds, tid, lane, wave); continue; } it -= 16;
                    if (it < 16) { if (EN(7)) scan_item<64, false>(li, 32 + (it >> 3), (it >> 1) & 3, it & 1, lds, tid, lane, wave); continue; } it -= 16;
                    if (it < 64) { if (EN(9)) hyena_item<0>(li, 32 + (it >> 5), (it >> 3) & 3, (it & 7) * 8 + wave, lane); continue; } it -= 64;
                    if (it < 256) { if (EN(6)) scan_item<128, true>(li, it >> 3, (it >> 1) & 3, it & 1, lds, tid, lane, wave); continue; } it -= 256;
                    if (it < 224) { const int kt = it % 7, r = it / 7, qb = r & 7, kvh = (r >> 3) & 1, b = r >> 4;
                        if ((kt == 4 && qb == 0) || (kt == 6 && qb == 7)) continue;
                        if (EN(8)) attn_item(li, 32 + b, kvh, qb, kt, lds, tid, lane, wave); continue; } it -= 224;
                    if (it < 256) { if (EN(7)) scan_item<64, false>(li, it >> 3, (it >> 1) & 3, it & 1, lds, tid, lane, wave); continue; } it -= 256;
                    if (it < 256) { if (EN(8)) attn_item(li, it >> 3, (it >> 2) & 1, (it >> 1) & 1, it & 1, lds, tid, lane, wave); continue; } it -= 256;
                    if (EN(9)) hyena_item<0>(li, it >> 3, (it >> 1) & 3, (it & 1) * 8 + wave, lane);
                }
            } else if (k == 7) {
                for (;;) {
                    int it = dq_next(ctl + ph, qslot, threadIdx.x);
                    if (it >= 1600) break;
                    int tid = threadIdx.x, li = (ph - 1) / 12; asm volatile("" : "+v"(tid)); asm volatile("" : "+s"(li));
                    const int lane = tid & 63, wave = __builtin_amdgcn_readfirstlane(tid >> 6);
                    if (it < 64) { if (EN(10)) hyena_item<1>(li, 32 + (it >> 5), (it >> 3) & 3, (it & 7) * 8 + wave, lane); continue; } it -= 64;
                    if (it < 256) { if (EN(10)) hyena_item<1>(li, it >> 3, (it >> 1) & 3, (it & 1) * 8 + wave, lane); continue; } it -= 256;
                    if (EN(11)) finalize_token(li, it * 8 + wave, lane);
                }
            }
        }
        if (ph + 1 < ph_hi) {
            if (ph == 0) cg::this_grid().sync();
            else xcd_barrier((unsigned*)(AWS() + WS_CTL) + CW_BAR, (volatile LAS unsigned*)((LAS unsigned char*)lds + 131072 + 128));
        }
    }

}

extern "C" void kernel_launch(void* const* d_in, const int* in_sizes, int n_in, void* d_out, int out_size, void* d_ws, size_t ws_size, hipStream_t stream) {
    static int grid = 0;
    if (grid == 0) {
        if (n_in != 35 || ws_size < WS_END) { fprintf(stderr, "kernel_launch: unexpected n_in %d / ws %zu\n", n_in, ws_size); grid = -1; return; }
        int dev = 0, cus = 0, per_cu = 0;
        hipGetDevice(&dev);
        hipDeviceGetAttribute(&cus, hipDeviceAttributeMultiprocessorCount, dev);
        if (hipFuncSetAttribute((const void*)mk_fwd, hipFuncAttributeMaxDynamicSharedMemorySize, LDS_BYTES) != hipSuccess) { fprintf(stderr, "kernel_launch: hipFuncSetAttribute failed\n"); grid = -1; return; }
        if (hipOccupancyMaxActiveBlocksPerMultiprocessor(&per_cu, (const void*)mk_fwd, NTHR, LDS_BYTES) != hipSuccess || per_cu < 1) { fprintf(stderr, "kernel_launch: occupancy query says %d\n", per_cu); per_cu = 1; }
        (void)hipGetLastError();
        if (per_cu > 1) per_cu = 1;
        grid = cus * per_cu;
    }
    if (grid < 0) return;
    hipMemsetAsync((char*)d_ws + WS_CTL, 0, CTL_ZERO_BYTES, stream);
    Args a{};
    for (int i = 0; i < 35; ++i) a.in[i] = (const float*)d_in[i];
    a.out = (float*)d_out; a.ws = (unsigned char*)d_ws;
#if MK_MULTI
    for (int ph = 0; ph < NPHASE; ++ph) { a.ph_lo = ph; a.ph_hi = ph + 1; hipLaunchKernelGGL(mk_fwd, dim3(grid), dim3(NTHR), LDS_BYTES, stream, a); }
#else
    a.ph_lo = 0; a.ph_hi = NPHASE + (MK_KEEP != 0x3F ? 1 : 0);
    void* args[] = {&a};
    hipError_t e = hipLaunchCooperativeKernel((const void*)mk_fwd, dim3(grid), dim3(NTHR), args, LDS_BYTES, stream);
    if (e != hipSuccess) fprintf(stderr, "cooperative launch failed: %s (grid %d)\n", hipGetErrorString(e), grid);
#endif
}
```

```cpp
#include <hip/hip_runtime.h>
#include <hip/hip_cooperative_groups.h>
#include <cstdio>
#include <cstdint>
namespace cg = cooperative_groups;

#ifndef MK_EN
#define MK_EN 0xFFFF
#endif
#define EN(b) ((MK_EN >> (b)) & 1)
#ifndef MK_KEEP
#define MK_KEEP 0x3F
#endif
#ifndef MK_REP
#define MK_REP 0
#endif
#define REP(b) ((MK_REP >> (b)) & 1)
#ifndef MK_MULTI
#define MK_MULTI 0
#endif

#define GAS __attribute__((address_space(1)))
#define LAS __attribute__((address_space(3)))
typedef unsigned short bf16;
typedef float f32x4 __attribute__((ext_vector_type(4)));
typedef float f32x2 __attribute__((ext_vector_type(2)));
typedef unsigned u32x4 __attribute__((ext_vector_type(4)));
typedef unsigned u32x2 __attribute__((ext_vector_type(2)));
typedef unsigned short u16x4 __attribute__((ext_vector_type(4)));

namespace pg8 {
#define PG8_LAS __attribute__((address_space(3)))
typedef unsigned short bf16_t;
typedef short bf16x8 __attribute__((ext_vector_type(8)));
constexpr int BM = 256, BK = 64, HALF = 128, HTB = HALF * BK * 2, STAGE_BYTES = 8 * HTB, NXCD = 8, WGM = 8;

__host__ __device__ __forceinline__ int lds_byte(int r, int c) { const int st = (r >> 4) * 2 + (c >> 5), rr = r & 15, cc = c & 31, ob = rr * 64 + cc * 2; return st * 1024 + (ob ^ (((ob >> 9) & 1) << 5)); }
__host__ __device__ __forceinline__ void stage_rc(int b, int& R, int& C) { const int st = b / 1024, sb = b % 1024, swz = sb ^ (((sb >> 9) & 1) << 5); R = (st >> 1) * 16 + swz / 64; C = (st & 1) * 32 + (swz % 64) / 2; }
__host__ __device__ __forceinline__ int perm32(int rho) { const int n = rho >> 4, i = rho & 15; return 8 * (i >> 2) + 4 * n + (i & 3); }

struct Unit { int pm, pn; };
struct Gemm { const bf16_t* A; const bf16_t* Bt; int M, N, K; };

struct StaticOrder {
    int nM, nN, nwg, G, c;
    __host__ __device__ void init(int M, int N, int G_, int c_) { nM = M / BM; nN = N / BM; nwg = nM * nN; G = G_; c = c_; }
    __host__ __device__ bool next(int i, Unit& u) const {
        const long L = (long)i * G + c; if (L >= nwg) return false;
        int wgid = (int)L; { const int q = nwg / NXCD, r = nwg % NXCD, xcd = wgid % NXCD, off = wgid / NXCD; wgid = (xcd < r ? xcd * (q + 1) : r * (q + 1) + (xcd - r) * q) + off; }
        const int nig = WGM * nN, gid = wgid / nig, fm = gid * WGM, gsz = (nM - fm) < WGM ? (nM - fm) : WGM;
        u.pm = fm + ((wgid % nig) % gsz); u.pn = (wgid % nig) / gsz; return true;
    }
    __device__ __forceinline__ void a_ready(const Unit&) const {}
    __device__ __forceinline__ void done(const Unit&) const {}
};

__device__ __forceinline__ unsigned cvt_pk_bf16(float lo, float hi) { unsigned r; asm volatile("v_cvt_pk_bf16_f32 %0, %1, %2" : "=v"(r) : "v"(lo), "v"(hi)); return r; }
__device__ __forceinline__ float silu_f(float v) { return v * __builtin_amdgcn_rcpf(1.0f + __expf(-v)); }

struct EpiSwiglu {
    static constexpr bool PERM = true, AFTER_DRAIN = false;
    bf16_t* O; int ldc;
    __device__ __forceinline__ void operator()(const f32x4 (&acc)[2][2][4][2], const Unit& u, int wr, int wc, int fr, int fq) const {
        const int row0 = u.pm * BM + wr * 64 + fr, col0 = u.pn * HALF + wc * 32 + 8 * fq;
#pragma unroll
        for (int ai = 0; ai < 2; ++ai)
#pragma unroll
            for (int m = 0; m < 4; ++m) { bf16_t* rowp = O + (size_t)(row0 + ai * HALF + m * 16) * ldc + col0;
                const f32x4 g0 = acc[ai][0][m][0], g1 = acc[ai][0][m][1], u0 = acc[ai][1][m][0], u1 = acc[ai][1][m][1];
                u32x4 w;
                w.x = cvt_pk_bf16(silu_f(g0[0]) * u0[0], silu_f(g0[1]) * u0[1]); w.y = cvt_pk_bf16(silu_f(g0[2]) * u0[2], silu_f(g0[3]) * u0[3]);
                w.z = cvt_pk_bf16(silu_f(g1[0]) * u1[0], silu_f(g1[1]) * u1[1]); w.w = cvt_pk_bf16(silu_f(g1[2]) * u1[2], silu_f(g1[3]) * u1[3]);
                *(u32x4*)rowp = w; }
    }
};
struct EpiBf16 {
    static constexpr bool PERM = true, AFTER_DRAIN = false;
    bf16_t* O; int ldc;
    __device__ __forceinline__ void operator()(const f32x4 (&acc)[2][2][4][2], const Unit& u, int wr, int wc, int fr, int fq) const {
        const int row0 = u.pm * BM + wr * 64 + fr, col0 = u.pn * BM + wc * 32 + 8 * fq;
#pragma unroll
        for (int ai = 0; ai < 2; ++ai)
#pragma unroll
            for (int m = 0; m < 4; ++m) { bf16_t* rowp = O + (size_t)(row0 + ai * HALF + m * 16) * ldc + col0;
#pragma unroll
                for (int bj = 0; bj < 2; ++bj) { const f32x4 v0 = acc[ai][bj][m][0], v1 = acc[ai][bj][m][1];
                    u32x4 w; w.x = cvt_pk_bf16(v0[0], v0[1]); w.y = cvt_pk_bf16(v0[2], v0[3]); w.z = cvt_pk_bf16(v1[0], v1[1]); w.w = cvt_pk_bf16(v1[2], v1[3]);
                    *(u32x4*)(rowp + bj * HALF) = w; } }
    }
};
struct EpiResid {
    static constexpr bool PERM = false, AFTER_DRAIN = false;
    const float* xin_ctx; const float* xin_lat; float* out; const float* gate; float scale;
    __device__ __forceinline__ void operator()(const f32x4 (&acc)[2][2][4][2], const Unit& u, int wr, int wc, int fr, int fq) const {
        const int row0 = u.pm * BM + wr * 64 + fr, col0 = u.pn * BM + wc * 32 + 4 * fq;
        const int cidx = u.pm < 32 ? 0 : 1 + ((u.pm - 32) >> 2);
        const float* xin = u.pm < 32 ? xin_ctx : xin_lat;
        const float* gp = gate + cidx * 9216 + col0;
        f32x4 gv[2][2];
#pragma unroll
        for (int bj = 0; bj < 2; ++bj)
#pragma unroll
            for (int n = 0; n < 2; ++n) gv[bj][n] = *(const f32x4*)(gp + bj * HALF + n * 16) * scale;
#pragma unroll
        for (int ai = 0; ai < 2; ++ai)
#pragma unroll
            for (int m = 0; m < 4; ++m) { const size_t off = (size_t)(row0 + ai * HALF + m * 16) * 1024 + col0;
#pragma unroll
                for (int bj = 0; bj < 2; ++bj)
#pragma unroll
                    for (int n = 0; n < 2; ++n) { const f32x4 xv = *(const f32x4*)(xin + off + bj * HALF + n * 16);
                        *(f32x4*)(out + off + bj * HALF + n * 16) = xv + gv[bj][n] * acc[ai][bj][m][n]; } }
    }
};

template <class Epi, class Sched, bool ALIGN_EPI = false, bool SP2 = false>
__device__ __forceinline__ void gemm_phase(PG8_LAS unsigned char* lds, const Gemm g, const Sched& S, const Epi& E, const int tid) {
    const int wid = __builtin_amdgcn_readfirstlane(tid >> 6), lane = tid & 63, wr = wid >> 2, wc = wid & 3, fr = lane & 15, fq = lane >> 4;
    const int K = g.K, nt = K / BK;
    unsigned voffA[2], voffB[2];
#pragma unroll
    for (int i = 0; i < 2; ++i) { int R, C; stage_rc(tid * 16 + i * 8192, R, C); const int Rb = Epi::PERM ? ((R & ~31) + perm32(R & 31)) : R;
        voffA[i] = (unsigned)(R * K + C) * 2u; voffB[i] = (unsigned)(Rb * K + C) * 2u; }
    const size_t kstep = (size_t)(BK * 2);
    const size_t hstep = (size_t)HALF * K * 2;
    const size_t tstep = 2 * hstep;
    const unsigned ldsw = (unsigned)wid * 1024u;
    const int aoff = lds_byte(wr * 64 + fr, fq * 8), boff = lds_byte(wc * 32 + fr, fq * 8);
#define PG8_SA(b, h) (((b) * 2 + (h)) * HTB)
#define PG8_SB(b, h) ((4 + (b) * 2 + (h)) * HTB)
#define PG8_STAGE(bufoff, gbase, voff) do { _Pragma("unroll") for (int _i = 0; _i < 2; ++_i) \
        __builtin_amdgcn_global_load_lds((const unsigned*)((const char*)(gbase) + (voff)[_i]), (PG8_LAS unsigned*)(lds + (bufoff) + ldsw + _i * 8192), 16, 0, 0); } while (0)
#define PG8_LDA(dst, b, h) do { _Pragma("unroll") for (int m = 0; m < 4; ++m) _Pragma("unroll") for (int k = 0; k < 2; ++k) dst[m][k] = *(const PG8_LAS bf16x8*)(lds + PG8_SA(b, h) + aoff + m * 2048 + k * 1024); } while (0)
#define PG8_LDB(dst, b, h) do { _Pragma("unroll") for (int n = 0; n < 2; ++n) _Pragma("unroll") for (int k = 0; k < 2; ++k) dst[n][k] = *(const PG8_LAS bf16x8*)(lds + PG8_SB(b, h) + boff + n * 2048 + k * 1024); } while (0)
#define PG8_MMA(ai, bj, At, Bt) do { __builtin_amdgcn_s_setprio(1); _Pragma("unroll") for (int m = 0; m < 4; ++m) _Pragma("unroll") for (int n = 0; n < 2; ++n) _Pragma("unroll") for (int k = 0; k < 2; ++k) \
        acc[ai][bj][m][n] = __builtin_amdgcn_mfma_f32_16x16x32_bf16(Bt[n][k], At[m][k], acc[ai][bj][m][n], 0, 0, 0); __builtin_amdgcn_s_setprio(0); } while (0)
#define PG8_WAIT_V(n) asm volatile("s_waitcnt vmcnt(" #n ")" ::: "memory")
#define PG8_WAIT_L(n) asm volatile("s_waitcnt lgkmcnt(" #n ")" ::: "memory")
#define PG8_BAR __builtin_amdgcn_s_barrier()
#define PG8_SCHED __builtin_amdgcn_sched_barrier(0)
    Unit cur, nxt; int ui = 0;
    if (!S.next(0, cur)) return;
    f32x4 acc[2][2][4][2];
#pragma unroll
    for (int a = 0; a < 2; ++a)
#pragma unroll
        for (int b = 0; b < 2; ++b)
#pragma unroll
            for (int m = 0; m < 4; ++m)
#pragma unroll
                for (int n = 0; n < 2; ++n) acc[a][b][m][n] = (f32x4){0.f, 0.f, 0.f, 0.f};
    bf16x8 At[4][2], B0[2][2], B1[2][2];
    const char* cA = (const char*)g.A + (size_t)cur.pm * tstep; const char* cB = (const char*)g.Bt + (size_t)cur.pn * tstep;
    S.a_ready(cur);
    if constexpr (SP2) {
        PG8_STAGE(PG8_SB(0, 0), cB, voffB); PG8_STAGE(PG8_SB(0, 1), cB + hstep, voffB); PG8_STAGE(PG8_SA(0, 0), cA, voffA); PG8_STAGE(PG8_SA(0, 1), cA + hstep, voffA);
        if (wr == 1) PG8_BAR;
        PG8_WAIT_V(2); PG8_BAR;
        PG8_STAGE(PG8_SB(1, 0), cB + kstep, voffB); PG8_STAGE(PG8_SA(1, 0), cA + kstep, voffA); PG8_STAGE(PG8_SB(1, 1), cB + hstep + kstep, voffB);
        PG8_WAIT_V(6); PG8_BAR;
    } else {
        PG8_STAGE(PG8_SB(0, 0), cB, voffB); PG8_STAGE(PG8_SA(0, 0), cA, voffA); PG8_STAGE(PG8_SB(0, 1), cB + hstep, voffB); PG8_STAGE(PG8_SA(0, 1), cA + hstep, voffA);
        if (wr == 1) PG8_BAR;
        PG8_WAIT_V(4); PG8_BAR;
        PG8_STAGE(PG8_SB(1, 0), cB + kstep, voffB); PG8_STAGE(PG8_SA(1, 0), cA + kstep, voffA); PG8_STAGE(PG8_SB(1, 1), cB + hstep + kstep, voffB);
        PG8_WAIT_V(6); PG8_BAR;
    }
    for (;;) {
        const bool has_next = S.next(ui + 1, nxt);
        const char* nA = has_next ? (const char*)g.A + (size_t)nxt.pm * tstep : cA; const char* nB = has_next ? (const char*)g.Bt + (size_t)nxt.pn * tstep : cB;
        for (int t = 0; t < nt; t += 2) {
            const bool last = (t == nt - 2);
            const char* a1 = cA + (size_t)(t + 1) * kstep;
            const char* a2 = last ? nA : cA + (size_t)(t + 2) * kstep; const char* b2 = last ? nB : cB + (size_t)(t + 2) * kstep;
            const char* a3 = a2 + kstep; const char* b3 = b2 + kstep;
            if (last && has_next) S.a_ready(nxt);
            if constexpr (SP2) {
            PG8_LDB(B0, 0, 0); PG8_LDB(B1, 0, 1); PG8_SCHED; PG8_LDA(At, 0, 0); PG8_STAGE(PG8_SA(1, 1), a1 + hstep, voffA);
            PG8_WAIT_V(8); PG8_WAIT_L(0); PG8_BAR; PG8_MMA(0, 0, At, B0); PG8_MMA(0, 1, At, B1); PG8_BAR; PG8_SCHED;
            PG8_LDA(At, 0, 1); PG8_STAGE(PG8_SB(0, 0), b2, voffB); PG8_STAGE(PG8_SB(0, 1), b2 + hstep, voffB); PG8_STAGE(PG8_SA(0, 0), a2, voffA);
            PG8_WAIT_V(8); PG8_WAIT_L(0); PG8_BAR; PG8_MMA(1, 0, At, B0); PG8_MMA(1, 1, At, B1); PG8_BAR; PG8_SCHED;
            PG8_LDB(B0, 1, 0); PG8_LDB(B1, 1, 1); PG8_SCHED; PG8_LDA(At, 1, 0); PG8_STAGE(PG8_SA(0, 1), a2 + hstep, voffA);
            PG8_WAIT_V(8); PG8_WAIT_L(0); PG8_BAR; PG8_MMA(0, 0, At, B0); PG8_MMA(0, 1, At, B1); PG8_BAR; PG8_SCHED;
            PG8_LDA(At, 1, 1); PG8_STAGE(PG8_SB(1, 0), b3, voffB); PG8_STAGE(PG8_SB(1, 1), b3 + hstep, voffB); PG8_STAGE(PG8_SA(1, 0), a3, voffA);
            PG8_WAIT_V(8); PG8_WAIT_L(0); PG8_BAR; PG8_MMA(1, 0, At, B0); PG8_MMA(1, 1, At, B1); PG8_BAR; PG8_SCHED;
            } else {
            PG8_LDB(B0, 0, 0); PG8_SCHED; PG8_LDA(At, 0, 0); PG8_STAGE(PG8_SA(1, 1), a1 + hstep, voffA);
            PG8_WAIT_L(8); PG8_BAR; PG8_WAIT_L(0); PG8_MMA(0, 0, At, B0); PG8_BAR; PG8_SCHED;
            PG8_LDB(B1, 0, 1); PG8_STAGE(PG8_SB(0, 0), b2, voffB);
            PG8_BAR; PG8_WAIT_L(0); PG8_MMA(0, 1, At, B1); PG8_BAR;
            PG8_LDA(At, 0, 1); PG8_STAGE(PG8_SA(0, 0), a2, voffA);
            PG8_BAR; PG8_WAIT_L(0); PG8_MMA(1, 0, At, B0); PG8_BAR; PG8_SCHED;
            PG8_STAGE(PG8_SB(0, 1), b2 + hstep, voffB);
            PG8_WAIT_V(6); PG8_BAR; PG8_MMA(1, 1, At, B1); PG8_BAR;
            PG8_LDB(B0, 1, 0); PG8_SCHED; PG8_LDA(At, 1, 0); PG8_STAGE(PG8_SA(0, 1), a2 + hstep, voffA);
            PG8_WAIT_L(8); PG8_BAR; PG8_WAIT_L(0); PG8_MMA(0, 0, At, B0); PG8_BAR; PG8_SCHED;
            PG8_LDB(B1, 1, 1); PG8_STAGE(PG8_SB(1, 0), b3, voffB);
            PG8_BAR; PG8_WAIT_L(0); PG8_MMA(0, 1, At, B1); PG8_BAR;
            PG8_LDA(At, 1, 1); PG8_STAGE(PG8_SA(1, 0), a3, voffA);
            PG8_BAR; PG8_WAIT_L(0); PG8_MMA(1, 0, At, B0); PG8_BAR; PG8_SCHED;
            PG8_STAGE(PG8_SB(1, 1), b3 + hstep, voffB);
            PG8_WAIT_V(6); PG8_BAR; PG8_MMA(1, 1, At, B1); PG8_BAR;
            }
        }
        if constexpr (ALIGN_EPI) { if (wr == 0) PG8_BAR; }
        if constexpr (!Epi::AFTER_DRAIN) { E(acc, cur, wr, wc, fr, fq); S.done(cur); }
        if (!has_next) break;
#pragma unroll
        for (int a = 0; a < 2; ++a)
#pragma unroll
            for (int b = 0; b < 2; ++b)
#pragma unroll
                for (int m = 0; m < 4; ++m)
#pragma unroll
                    for (int n = 0; n < 2; ++n) acc[a][b][m][n] = (f32x4){0.f, 0.f, 0.f, 0.f};
        cur = nxt; cA = nA; cB = nB; ++ui;
        if constexpr (ALIGN_EPI) { if (wr == 1) PG8_BAR; }
    }
    PG8_WAIT_V(0);
    if constexpr (!ALIGN_EPI) { if (wr == 0) PG8_BAR; }
    PG8_BAR;
#undef PG8_SA
#undef PG8_SB
#undef PG8_STAGE
#undef PG8_LDA
#undef PG8_LDB
#undef PG8_MMA
#undef PG8_WAIT_V
#undef PG8_WAIT_L
#undef PG8_BAR
#undef PG8_SCHED
}
}

constexpr int NTHR = 512, NWAVES = 8;
constexpr int D = 1024, TCTX = 8192, TLAT = 2048, TT = 10240, DFF = 2816;
constexpr int DIN = 3336, DINP = 3584;
constexpr int U_Z = 0, U_XBC = 256, U_DT = 1024, U_HY = 1032, U_RET = 1800, U_ATT = 2824;
constexpr float EPS = 1e-6f;
constexpr int NPHASE = 25;

constexpr size_t MiB = 1u << 20;
constexpr size_t WS_CTL = 0, CTL_ZERO_BYTES = 65536;
constexpr int CW_BAR = 4096;
constexpr size_t WS_MOD = 1 * MiB;
constexpr size_t WS_HK = 2 * MiB, HK_LAYER = 6 * MiB, HK1024_OFF = 1310720;
constexpr size_t WS_W = 14 * MiB, W_LAYER = 42 * MiB;
constexpr size_t W_IN0 = 0, W_IN1 = 11 * MiB, W_OUT0 = 22 * MiB, W_OUT1 = 22 * MiB + 5767168, W_MI = 33 * MiB, W_MO = 40 * MiB;
constexpr size_t WS_H = 98 * MiB;
constexpr size_t WS_YMIX = 118 * MiB;
constexpr size_t WS_UA = 138 * MiB;
constexpr size_t WS_XBC = 208 * MiB;
constexpr size_t WS_QK = 238 * MiB;
constexpr size_t WS_YS = 253 * MiB;
constexpr size_t WS_YR = 273 * MiB;
constexpr size_t WS_Z1 = 293 * MiB;
constexpr size_t WS_APC = 303 * MiB;
constexpr size_t WS_APL = 320 * MiB;
constexpr size_t WS_END = 335 * MiB;
constexpr size_t APC_ML = (size_t)8192 * 4 * 2 * 64 * 4, APL_ML = (size_t)2048 * 4 * 7 * 64 * 4;

constexpr size_t O_Y = 0, O_CK = 10485760, O_CV = 12582912, O_SSD = 14680064, O_RET = 18874368;

constexpr int LDS_BYTES = 147456;

struct Args { const float* in[35]; float* out; unsigned char* ws; int ph_lo, ph_hi; };
typedef const __attribute__((address_space(4))) unsigned char* kargp_t;
__device__ __forceinline__ unsigned long long karg_u64(int off) { asm volatile("" : "+s"(off)); kargp_t kp = (kargp_t)__builtin_amdgcn_kernarg_segment_ptr(); return *(const __attribute__((address_space(4))) unsigned long long*)(kp + off); }
__device__ __forceinline__ int karg_i32(int off) { asm volatile("" : "+s"(off)); kargp_t kp = (kargp_t)__builtin_amdgcn_kernarg_segment_ptr(); return *(const __attribute__((address_space(4))) int*)(kp + off); }
#define INP(i) ((const float*)(const GAS float*)karg_u64(8 * (i)))
#define AOUT() ((float*)(GAS float*)karg_u64(8 * 35))
#define AWS() ((unsigned char*)(GAS unsigned char*)karg_u64(8 * 36))


#define LDS_WAIT() asm volatile("s_waitcnt lgkmcnt(0)" ::: "memory")
__device__ __forceinline__ float bf2f(unsigned short b) { return __uint_as_float(((unsigned)b) << 16); }
__device__ __forceinline__ unsigned f2bf(float f) { unsigned u = __float_as_uint(f); return (u + 0x7fffu + ((u >> 16) & 1u)) >> 16; }
__device__ __forceinline__ unsigned pk2(float lo, float hi) { return f2bf(lo) | (f2bf(hi) << 16); }
__device__ __forceinline__ float wave_sum(float v) {
#pragma unroll
    for (int o = 1; o < 64; o <<= 1) v += __shfl_xor(v, o);
    return v;
}
__device__ __forceinline__ float siluf(float v) { return v / (1.0f + __expf(-v)); }
__device__ __forceinline__ void seq_info(int sq, int& L, int& base) { if (sq < 32) { L = 256; base = sq * 256; } else { L = 1024; base = TCTX + (sq - 32) * 1024; } }

__device__ __forceinline__ void transpose_item(const float* __restrict__ W, int K, int Nsrc, bf16* WT, int k0, int n0, int drow0, LAS float* scr, int lane) {
    const int nn = n0 + (lane & 31); const bool ok = nn < Nsrc;
#pragma unroll 8
    for (int i = 0; i < 32; ++i) { const int kk = 2 * i + (lane >> 5); scr[kk * 33 + (lane & 31)] = ok ? W[(size_t)(k0 + kk) * Nsrc + nn] : 0.f; }
    LDS_WAIT();
    const int c = lane & 7;
#pragma unroll
    for (int j = 0; j < 4; ++j) { const int n = (lane >> 3) + 8 * j; const LAS float* s = scr + (8 * c) * 33 + n;
        u32x4 o; o.x = pk2(s[0 * 33], s[1 * 33]); o.y = pk2(s[2 * 33], s[3 * 33]); o.z = pk2(s[4 * 33], s[5 * 33]); o.w = pk2(s[6 * 33], s[7 * 33]);
        *(u32x4*)(WT + (size_t)(drow0 + n) * K + k0 + 8 * c) = o; }
    LDS_WAIT();
}

__device__ __forceinline__ void phase0(unsigned char* lds, int tid, int lane, int wave, int G) {
    const int bid = blockIdx.x;
    float* fl = (float*)lds;
    {
        const float* cc = INP(6); const float* cctx = INP(7); const float* wmod = INP(8); const float* bmod = INP(9);
        float* mod = (float*)(AWS() + WS_MOD);
        float* sc = fl;
        float* red = fl + 3072;
        for (int i = tid; i < 3072; i += NTHR) { const int ci = i >> 10, k = i & 1023; const float v = ci == 0 ? cctx[k] : cc[(ci - 1) * 1024 + k]; sc[i] = siluf(v); }
        __syncthreads();
        for (int it = bid; it < 288; it += G) {
            const int l = it / 144, col = (it % 144) * 64 + lane;
            const float* wp = wmod + ((size_t)l * 1024 + wave * 128) * 9216 + col;
            float a0 = 0.f, a1 = 0.f, a2 = 0.f;
#pragma unroll 8
            for (int k = 0; k < 128; ++k) { const float w = wp[(size_t)k * 9216]; const int kk = wave * 128 + k; a0 += sc[kk] * w; a1 += sc[1024 + kk] * w; a2 += sc[2048 + kk] * w; }
            red[(wave * 3 + 0) * 64 + lane] = a0; red[(wave * 3 + 1) * 64 + lane] = a1; red[(wave * 3 + 2) * 64 + lane] = a2;
            __syncthreads();
            if (tid < 192) { const int ci = tid >> 6, ln = tid & 63; float s = bmod[l * 9216 + (it % 144) * 64 + ln];
#pragma unroll
                for (int w = 0; w < 8; ++w) s += red[(w * 3 + ci) * 64 + ln];
                mod[((size_t)l * 3 + ci) * 9216 + (it % 144) * 64 + ln] = s; }
            __syncthreads();
        }
    }
    __syncthreads();
    {
        float* feats = fl;
        float* h1 = fl + 512;
        float* h2 = fl + 1024;
        const float MIN_DECAY = -3.0701134573253945f, MAX_DECAY = -15.350567286626973f;
        for (int it = bid; it < 320; it += G) {
            const int l = it / 160, r = it % 160; const int L = r < 32 ? 256 : 1024; const int pg = r < 32 ? r : r - 32;
            const float* w1 = INP(23) + l * 33 * 64; const float* b1 = INP(24) + l * 64; const float* w2 = INP(25) + l * 64 * 64; const float* b2 = INP(26) + l * 64;
            const float* w3 = INP(27) + (size_t)l * 64 * 1024; const float* fr = INP(28) + l * 64; const float* hb = INP(29) + l * 512;
            float* Hk = (float*)(AWS() + WS_HK + (size_t)l * HK_LAYER + (L == 256 ? 0 : HK1024_OFF));
            if (tid < 8 * 33) { const int pl = tid / 33, j = tid % 33; const float pos = (float)(pg * 8 + pl); float f;
                if (j == 0) f = pos / (float)(L - 1);
                else { const int b = (j - 1) & 15; const float band = 1e-4f + (float)b * ((15.0f - 1e-4f) / 15.0f); const float ang = (6.283185307179586f / (float)L) * pos * band; f = j <= 16 ? cosf(ang) : -sinf(ang); }
                feats[pl * 36 + j] = f; }
            __syncthreads();
            { const int pl = tid >> 6, j = tid & 63; float s = b1[j];
                for (int k = 0; k < 33; ++k) s += feats[pl * 36 + k] * w1[k * 64 + j];
                h1[pl * 64 + j] = sinf(fr[j] * s); }
            __syncthreads();
            { const int pl = tid >> 6, j = tid & 63; float s = b2[j];
                for (int k = 0; k < 64; ++k) s += h1[pl * 64 + k] * w2[k * 64 + j];
                h2[pl * 64 + j] = sinf(fr[j] * s); }
            __syncthreads();
#pragma unroll
            for (int cc = 0; cc < 2; ++cc) {
                const int col = tid + cc * 512;
                float acc[8];
#pragma unroll
                for (int p = 0; p < 8; ++p) acc[p] = 0.f;
                for (int k = 0; k < 64; ++k) { const float w = w3[k * 1024 + col];
#pragma unroll
                    for (int p = 0; p < 8; ++p) acc[p] += h2[p * 64 + k] * w; }
                const int c = col & 255, o = (col >> 8) & 1, dir = col >> 9;
                const float delta = fabsf(MIN_DECAY + (float)c * ((MAX_DECAY - MIN_DECAY) / 255.0f));
                float* Ho = Hk + (size_t)o * (2 * L - 1) * 256 + c;
#pragma unroll
                for (int p = 0; p < 8; ++p) { const int pos = pg * 8 + p; const float t = (float)pos / (float)(L - 1);
                    float v = acc[p] * __expf(-t * delta);
                    if (dir == 0) { if (pos == 0) v += hb[o * 256 + c]; Ho[(size_t)(L - 1 + pos) * 256] = v; }
                    else if (pos > 0) Ho[(size_t)(L - 1 - pos) * 256] = v; }
            }
            __syncthreads();
        }
    }
    __syncthreads();
    {
        LAS float* scr = (LAS float*)((LAS unsigned char*)lds + wave * 16384);
        const int gw = bid * NWAVES + wave, NGW = G * NWAVES;
        constexpr int I_IN = 16 * 176, I_OUT = 44 * 32, I_MI = 16 * 112, I_MO = 16 * 32, I_LAYER = 2 * I_IN + 2 * I_OUT + I_MI + I_MO;
        for (int it = gw; it < 2 * I_LAYER; it += NGW) {
            const int l = it / I_LAYER; int r = it % I_LAYER;
            unsigned char* wl = AWS() + WS_W + (size_t)l * W_LAYER;
            if (r < 2 * I_IN) { const int f = r / I_IN; r %= I_IN; const int kb = r / 176, nb = r % 176, n0 = nb * 32;
                const int isup = n0 >= DFF, ff = isup ? n0 - DFF : n0; const int drow0 = (ff >> 7) * 256 + isup * 128 + (ff & 127);
                transpose_item(INP(11) + (size_t)(l * 2 + f) * 1024 * 5632, 1024, 5632, (bf16*)(wl + (f ? W_IN1 : W_IN0)), kb * 64, n0, drow0, scr, lane); continue; }
            r -= 2 * I_IN;
            if (r < 2 * I_OUT) { const int f = r / I_OUT; r %= I_OUT; const int kb = r / 32, nb = r % 32;
                transpose_item(INP(12) + (size_t)(l * 2 + f) * 2816 * 1024, 2816, 1024, (bf16*)(wl + (f ? W_OUT1 : W_OUT0)), kb * 64, nb * 32, nb * 32, scr, lane); continue; }
            r -= 2 * I_OUT;
            if (r < I_MI) { const int kb = r / 112, nb = r % 112;
                transpose_item(INP(13) + (size_t)l * 1024 * DIN, 1024, DIN, (bf16*)(wl + W_MI), kb * 64, nb * 32, nb * 32, scr, lane); continue; }
            r -= I_MI;
            { const int kb = r / 32, nb = r % 32;
                transpose_item(INP(14) + (size_t)l * 1024 * 1024, 1024, 1024, (bf16*)(wl + W_MO), kb * 64, nb * 32, nb * 32, scr, lane); }
        }
    }
}

__device__ __forceinline__ void prep_phase(const float* xc, const float* xl, const float* nw, const float* modl, int p, bf16* H, int gw, int NGW, int lane) {
    f32x4 wv[4];
#pragma unroll
    for (int j = 0; j < 4; ++j) wv[j] = *(const f32x4*)(nw + 4 * lane + 256 * j);
    for (int row = gw; row < TT; row += NGW) {
        const float* x = (row < TCTX ? xc : xl) + (size_t)row * D;
        const int cidx = row < TCTX ? 0 : 1 + ((row - TCTX) >> 10);
        const float* sh = modl + (size_t)cidx * 9216 + (3 * p) * 1024; const float* sc = sh + 1024;
        f32x4 v[4]; float ss = 0.f;
#pragma unroll
        for (int j = 0; j < 4; ++j) { v[j] = *(const f32x4*)(x + 4 * lane + 256 * j); ss += (v[j].x * v[j].x + v[j].y * v[j].y) + (v[j].z * v[j].z + v[j].w * v[j].w); }
        const float rstd = rsqrtf(wave_sum(ss) * (1.0f / D) + EPS);
#pragma unroll
        for (int j = 0; j < 4; ++j) { const f32x4 s1 = *(const f32x4*)(sc + 4 * lane + 256 * j), s0 = *(const f32x4*)(sh + 4 * lane + 256 * j);
            const f32x4 y = (v[j] * rstd * wv[j]) * (s1 + 1.0f) + s0;
            u32x2 o; o.x = pk2(y.x, y.y); o.y = pk2(y.z, y.w);
            *(u32x2*)(H + (size_t)row * D + 4 * lane + 256 * j) = o; }
    }
}

__device__ __forceinline__ void m1_phase(int li, int gw, int NGW, int lane) {
    const bf16* U = (const bf16*)(AWS() + WS_UA);
    bf16* XBC = (bf16*)(AWS() + WS_XBC); float* QK = (float*)(AWS() + WS_QK);
    const float* cw = INP(15) + li * 3 * 768; const float* cb = INP(16) + li * 768;
    const float* qw = INP(32) + li * 64; const float* kw = INP(33) + li * 64;
    const float qwl = qw[lane], kwl = kw[lane];
    const int hf = lane >> 5, ri = lane & 31, fi = ri & 15;
    const float inv = exp2f(-(float)fi * (13.287712379549449f / 16.0f));
    for (int tok = gw; tok < TT; tok += NGW) {
        int sq, pos, L;
        if (tok < TCTX) { sq = tok >> 8; pos = tok & 255; L = 256; } else { sq = 32 + ((tok - TCTX) >> 10); pos = (tok - TCTX) & 1023; L = 1024; }
        const bf16* ur = U + (size_t)tok * DINP;
#pragma unroll
        for (int i = 0; i < 12; ++i) { const int ch = lane + 64 * i;
            const float c0 = bf2f(ur[U_XBC + ch]);
            const float cm = pos > 0 ? bf2f(ur[U_XBC + ch - DINP]) : 0.f;
            const float cp = pos < L - 1 ? bf2f(ur[U_XBC + ch + DINP]) : 0.f;
            const float v = cb[ch] + cw[ch] * cm + cw[768 + ch] * c0 + cw[1536 + ch] * cp;
            XBC[(size_t)tok * 768 + ch] = (bf16)f2bf(siluf(v)); }
        float sn = 0.f, cs = 1.f;
        if (sq >= 32) { const float pv = hf ? (float)(pos & 63) : (float)(pos >> 6); sincosf(pv * inv, &sn, &cs); }
#pragma unroll
        for (int h = 0; h < 6; ++h) {
            const float x = bf2f(ur[U_ATT + h * 64 + lane]);
            const float ss = wave_sum(x * x);
            float y = x * rsqrtf(ss * (1.0f / 64.0f) + EPS) * (h < 4 ? qwl : kwl);
            if (h >= 4 && sq < 32) AOUT()[O_CK + ((((size_t)sq * 2 + li) * 256 + pos) * 2 + (h - 4)) * 64 + lane] = y;
            if (sq >= 32) { const float yp = __shfl_xor(y, 16); y = (ri < 16) ? y * cs - yp * sn : yp * sn + y * cs; }
            QK[(size_t)tok * 384 + h * 64 + lane] = y;
        }
        if (sq < 32) {
#pragma unroll
            for (int kv = 0; kv < 2; ++kv) AOUT()[O_CV + ((((size_t)sq * 2 + li) * 256 + pos) * 2 + kv) * 64 + lane] = bf2f(ur[U_ATT + 384 + kv * 64 + lane]);
        }
    }
}

typedef short sbf16x8 __attribute__((ext_vector_type(8)));
typedef float sf32x16 __attribute__((ext_vector_type(16)));
#define SC_MFMA(a, b, c) __builtin_amdgcn_mfma_f32_32x32x16_bf16((a), (b), (c), 0, 0, 0)
template <int N, bool SSD>
__device__ __forceinline__ void cscan_item(int li, int sq, int h, unsigned char* lds, int tid, int lane, int wave) {
    constexpr int RS = N + 8, TS = 72;
    constexpr int O_CQ = 0, O_BK = O_CQ + 64 * RS * 2, O_BKT = O_BK + 64 * RS * 2, O_VT = O_BKT + N * TS * 2, O_VWT = O_VT + 64 * TS * 2, O_ST = O_VWT + 64 * TS * 2,
                  O_YX = O_ST + 64 * RS * 2, O_SC = O_YX + 16384;
    static_assert(O_SC + 4096 <= 131072, "chunk scan LDS");
    constexpr int GR = 2 * (N / 8) + 8, R = (64 * GR) / NTHR;
    static_assert((64 * GR) % NTHR == 0, "chunk loader");
    int L, base; seq_info(sq, L, base);
    const int nch = L >> 6, g = h >> 1;
    const bf16* src = SSD ? (const bf16*)(AWS() + WS_XBC) : (const bf16*)(AWS() + WS_UA);
    const int sstr = SSD ? 768 : DINP;
    const int qoff = SSD ? 512 + g * 128 : U_RET + h * 64, koff = SSD ? 256 + g * 128 : U_RET + 256 + h * 64, voff = SSD ? h * 64 : U_RET + 512 + h * 64;
    float* Yout = (float*)(AWS() + (SSD ? WS_YS : WS_YR));
    float* sc = (float*)(lds + O_SC);
    const int r = lane & 31, hh = lane >> 5;
    float dtb_f = 0.f, dtb_b = 0.f, an_f = 0.f, an_b = 0.f;
    if (SSD) { dtb_f = INP(17)[(li * 2 + 0) * 4 + h]; dtb_b = INP(17)[(li * 2 + 1) * 4 + h]; an_f = -__expf(INP(18)[(li * 2 + 0) * 4 + h]); an_b = -__expf(INP(18)[(li * 2 + 1) * 4 + h]); }
    else { const float d0 = INP(30)[(li * 2 + 0) * 4 + h], d1 = INP(30)[(li * 2 + 1) * 4 + h];
        an_f = -log1pf(__expf(-d0)); an_b = -log1pf(__expf(-d1)); }
    const bool has_state = SSD || wave < 4;
    const int nt = SSD ? (wave & 3) : (wave & 1), pt_s = SSD ? (wave >> 2) : ((wave >> 1) & 1);
    const int it = wave & 1, pt = (wave >> 1) & 1, kh = wave >> 2;
    uint4 pre[R]; float p_raw_f = 0.f, p_raw_b = 0.f;

    for (int pass = 0; pass < 2; ++pass) {
        sf32x16 accS;
        if (has_state) {
            if (sq < 32) {
#pragma unroll
                for (int i = 0; i < 16; ++i) accS[i] = 0.f;
            } else {
                const float* s0 = INP(SSD ? 4 : 5) + ((((size_t)(sq - 32) * 2 + li) * 2 + pass) * 4 + h) * (size_t)(N * 64);
#pragma unroll
                for (int i = 0; i < 16; ++i) accS[i] = s0[(32 * nt + (i & 3) + 8 * (i >> 2) + 4 * hh) * 64 + 32 * pt_s + r];
            }
        }
        auto issue = [&](int c) {
#pragma unroll
            for (int q = 0; q < R; ++q) { const int gi0 = tid + NTHR * q, j = gi0 & 63, gi = gi0 >> 6; const size_t tok = (size_t)base + c * 64 + j;
                const int col = gi < N / 8 ? qoff + 8 * gi : (gi < N / 4 ? koff + 8 * (gi - N / 8) : voff + 8 * (gi - N / 4));
                pre[q] = *(const uint4*)(src + tok * sstr + col); }
            if (SSD && tid < 64) { const bf16* up = (const bf16*)(AWS() + WS_UA) + ((size_t)base + c * 64 + tid) * DINP + U_DT + h; p_raw_f = bf2f(up[0]); p_raw_b = bf2f(up[4]); }
        };
        issue(pass ? nch - 1 : 0);
        for (int cc = 0; cc < nch; ++cc) {
            const int c = pass ? nch - 1 - cc : cc;
            __syncthreads();
            if (wave == 0) {
                float dtf, dtbk, laf, lab;
                if (SSD) { const float xf = p_raw_f + dtb_f, xb = p_raw_b + dtb_b; dtf = xf > 20.f ? xf : log1pf(__expf(xf)); dtbk = xb > 20.f ? xb : log1pf(__expf(xb)); laf = dtf * an_f; lab = dtbk * an_b; }
                else { dtf = 0.125f; dtbk = 0.125f; laf = an_f; lab = an_b; }
                float cf = laf, rc = lab;
#pragma unroll
                for (int o = 1; o < 64; o <<= 1) { const float t1 = __shfl_up(cf, o), t2 = __shfl_down(rc, o); if (lane >= o) cf += t1; if (lane + o < 64) rc += t2; }
                const float cfl = __shfl(cf, 63), rc0 = __shfl(rc, 0);
                sc[lane] = cf; sc[64 + lane] = rc; sc[128 + lane] = dtf; sc[192 + lane] = dtbk;
                sc[256 + lane] = dtf * __expf(cfl - cf); sc[320 + lane] = dtbk * __expf(rc0 - rc);
                sc[384 + lane] = __expf(cf); sc[448 + lane] = __expf(rc);
                if (lane == 0) { sc[512] = __expf(cfl); sc[513] = __expf(rc0); }
            }
            __syncthreads();
            {
                const float* wsc = sc + (pass ? 320 : 256);
#pragma unroll
                for (int q = 0; q < R; ++q) { const int gi0 = tid + NTHR * q, j = gi0 & 63, gi = gi0 >> 6; const uint4 v = pre[q];
                    if (gi < N / 8) { *(uint4*)(lds + O_CQ + (j * RS + 8 * gi) * 2) = v; }
                    else if (gi < N / 4) { const int n0 = 8 * (gi - N / 8);
                        if (pass == 0) *(uint4*)(lds + O_BK + (j * RS + n0) * 2) = v;
                        bf16* bt = (bf16*)(lds + O_BKT) + n0 * TS + j; const unsigned w[4] = {v.x, v.y, v.z, v.w};
#pragma unroll
                        for (int e = 0; e < 4; ++e) { bt[(2 * e) * TS] = (bf16)(w[e] & 0xffffu); bt[(2 * e + 1) * TS] = (bf16)(w[e] >> 16); } }
                    else { const int p0 = 8 * (gi - N / 4); const float wj = wsc[j];
                        bf16* vt = (bf16*)(lds + O_VT) + p0 * TS + j; bf16* vw = (bf16*)(lds + O_VWT) + p0 * TS + j; const unsigned w[4] = {v.x, v.y, v.z, v.w};
#pragma unroll
                        for (int e = 0; e < 4; ++e) { const bf16 lo = (bf16)(w[e] & 0xffffu), hi = (bf16)(w[e] >> 16);
                            if (pass == 0) { vt[(2 * e) * TS] = lo; vt[(2 * e + 1) * TS] = hi; }
                            vw[(2 * e) * TS] = (bf16)f2bf(bf2f(lo) * wj); vw[(2 * e + 1) * TS] = (bf16)f2bf(bf2f(hi) * wj); } }
                }
                if (has_state) { bf16* st = (bf16*)(lds + O_ST) + (32 * pt_s + r) * RS + 32 * nt + 4 * hh;
#pragma unroll
                    for (int gq = 0; gq < 4; ++gq) { u32x2 o; o.x = pk2(accS[4 * gq], accS[4 * gq + 1]); o.y = pk2(accS[4 * gq + 2], accS[4 * gq + 3]); *(u32x2*)(st + 8 * gq) = o; } }
            }
            if (cc + 1 < nch) issue(pass ? c - 1 : c + 1);
            __syncthreads();
            sf32x16 accY, accQ;
#pragma unroll
            for (int i = 0; i < 16; ++i) { accY[i] = 0.f; accQ[i] = 0.f; }
            if (pass == 0) {
                sf32x16 gt;
#pragma unroll
                for (int i = 0; i < 16; ++i) gt[i] = 0.f;
                const unsigned char* ap = lds + O_BK + ((32 * kh + r) * RS + 8 * hh) * 2; const unsigned char* bp = lds + O_CQ + ((32 * it + r) * RS + 8 * hh) * 2;
#pragma unroll
                for (int s2 = 0; s2 < N / 16; ++s2) gt = SC_MFMA(*(const sbf16x8*)(ap + 32 * s2), *(const sbf16x8*)(bp + 32 * s2), gt);
                const float cfi = sc[32 * it + r], rci = sc[64 + 32 * it + r];
                float m[16];
#pragma unroll
                for (int e = 0; e < 16; ++e) { const int jl = (e & 3) + 8 * (e >> 2) + 4 * hh, j = 32 * kh + jl;
                    float f = 0.f;
                    if (kh < it || (kh == it && jl <= r)) f = sc[128 + j] * __expf(cfi - sc[j]);
                    if (kh > it || (kh == it && jl >= r)) f += sc[192 + j] * __expf(rci - sc[64 + j]);
                    m[e] = gt[e] * f; }
                const unsigned char* vp = lds + O_VT + ((32 * pt + r) * TS + 32 * kh + 4 * hh) * 2;
#pragma unroll
                for (int s2 = 0; s2 < 2; ++s2) {
                    u32x4 av; av.x = pk2(m[8 * s2 + 0], m[8 * s2 + 1]); av.y = pk2(m[8 * s2 + 2], m[8 * s2 + 3]); av.z = pk2(m[8 * s2 + 4], m[8 * s2 + 5]); av.w = pk2(m[8 * s2 + 6], m[8 * s2 + 7]);
                    const u32x2 b0 = *(const u32x2*)(vp + (16 * s2) * 2), b1 = *(const u32x2*)(vp + (16 * s2 + 8) * 2);
                    u32x4 bv; bv.x = b0.x; bv.y = b0.y; bv.z = b1.x; bv.w = b1.y;
                    accY = SC_MFMA(__builtin_bit_cast(sbf16x8, av), __builtin_bit_cast(sbf16x8, bv), accY);
                }
            }
            {
                const unsigned char* ap = lds + O_CQ + ((32 * it + r) * RS + (N / 2) * kh + 8 * hh) * 2; const unsigned char* bp = lds + O_ST + ((32 * pt + r) * RS + (N / 2) * kh + 8 * hh) * 2;
#pragma unroll
                for (int s2 = 0; s2 < N / 32; ++s2) accQ = SC_MFMA(*(const sbf16x8*)(ap + 32 * s2), *(const sbf16x8*)(bp + 32 * s2), accQ);
            }
            {
                const float* esc = sc + (pass ? 448 : 384) + 32 * it + 4 * hh;
#pragma unroll
                for (int e = 0; e < 16; ++e) accY[e] += esc[(e & 3) + 8 * (e >> 2)] * accQ[e];
            }
            float* yx = (float*)(lds + O_YX) + (it + 2 * pt) * 1024;
            if (kh == 1) {
#pragma unroll
                for (int e = 0; e < 16; ++e) yx[e * 64 + lane] = accY[e];
            }
            if (has_state) {
                const float dA = sc[512 + pass];
#pragma unroll
                for (int i = 0; i < 16; ++i) accS[i] *= dA;
                const unsigned char* ap = lds + O_BKT + ((32 * nt + r) * TS + 8 * hh) * 2; const unsigned char* bp = lds + O_VWT + ((32 * pt_s + r) * TS + 8 * hh) * 2;
#pragma unroll
                for (int s2 = 0; s2 < 4; ++s2) accS = SC_MFMA(*(const sbf16x8*)(ap + 32 * s2), *(const sbf16x8*)(bp + 32 * s2), accS);
            }
            __syncthreads();
            if (kh == 0) {
                float* yo = Yout + (size_t)pass * TT * 256 + ((size_t)base + c * 64 + 32 * it + 4 * hh) * 256 + h * 64 + 32 * pt + r;
#pragma unroll
                for (int e = 0; e < 16; ++e) yo[(size_t)((e & 3) + 8 * (e >> 2)) * 256] = accY[e] + yx[e * 64 + lane];
            }
        }
        if (has_state && sq < 32) {
            float* so = AOUT() + (SSD ? O_SSD : O_RET) + ((((size_t)sq * 2 + li) * 2 + pass) * 4 + h) * (size_t)(N * 64);
#pragma unroll
            for (int i = 0; i < 16; ++i) so[(32 * nt + (i & 3) + 8 * (i >> 2) + 4 * hh) * 64 + 32 * pt_s + r] = accS[i];
        }
    }
}

__device__ __forceinline__ void attn_item(int li, int sq, int kvh, int qb, int kt, unsigned char* lds, int tid, int lane, int wave) {
    int L, base; seq_info(sq, L, base);
    const bool lat = sq >= 32;
    const float* QK = (const float*)(AWS() + WS_QK); const bf16* U = (const bf16*)(AWS() + WS_UA);
    float* Ks = (float*)lds; float* Vs = Ks + 128 * 64;
    const int kb = qb + kt - 5;
    __syncthreads();
#pragma unroll
    for (int r = 0; r < 4; ++r) { const int e = tid + NTHR * r, j = e >> 4, c4 = (e & 15) * 4;
        f32x4 kq, vq;
        if (lat && kt < 4) { const size_t ci = ((((size_t)(sq - 32) * 2 + li) * 512 + kt * 128 + j) * 2 + kvh) * 64 + c4; kq = *(const f32x4*)(INP(2) + ci); vq = *(const f32x4*)(INP(3) + ci); }
        else { const size_t tok = (size_t)base + (lat ? kb : kt) * 128 + j; kq = *(const f32x4*)(QK + tok * 384 + 256 + kvh * 64 + c4);
            const u16x4 w = *(const u16x4*)(U + tok * DINP + U_ATT + 384 + kvh * 64 + c4); vq = (f32x4){bf2f(w.x), bf2f(w.y), bf2f(w.z), bf2f(w.w)}; }
        *(f32x4*)(Ks + j * 64 + c4) = kq; *(f32x4*)(Vs + j * 64 + c4) = vq; }
    const int pair = tid & 255, khalf = tid >> 8, qi = pair & 127, hh = pair >> 7, head = kvh * 2 + hh;
    const size_t qtok = (size_t)base + qb * 128 + qi;
    f32x4 q[16], o[16];
#pragma unroll
    for (int i = 0; i < 16; ++i) { q[i] = *(const f32x4*)(QK + qtok * 384 + head * 64 + 4 * i) * 0.125f; o[i] = (f32x4){0.f, 0.f, 0.f, 0.f}; }
    float m = -1e30f, l = 0.f;
    __syncthreads();
    const bool masked = lat && kt >= 4;
    const int qpos = qb * 128 + qi;
    for (int jj = 0; jj < 64; ++jj) {
        const int j = khalf * 64 + jj;
        f32x4 sa = (f32x4){0.f, 0.f, 0.f, 0.f};
#pragma unroll
        for (int i = 0; i < 16; ++i) sa += q[i] * *(const f32x4*)(Ks + j * 64 + 4 * i);
        const float s = (sa.x + sa.y) + (sa.z + sa.w);
        bool valid = true;
        if (masked) { const int d = qpos - (kb * 128 + j); valid = (d <= 128) && (d >= -128); }
        if (valid) {
            if (s > m) { const float corr = __expf(m - s); l *= corr;
#pragma unroll
                for (int i = 0; i < 16; ++i) o[i] *= corr;
                m = s; }
            const float pexp = __expf(s - m); l += pexp;
#pragma unroll
            for (int i = 0; i < 16; ++i) o[i] += pexp * *(const f32x4*)(Vs + j * 64 + 4 * i);
        }
    }
    __syncthreads();
    float* mg = (float*)lds + pair * 68;
    if (khalf == 1) { mg[0] = m; mg[1] = l;
#pragma unroll
        for (int i = 0; i < 16; ++i) *(f32x4*)(mg + 4 + 4 * i) = o[i]; }
    __syncthreads();
    if (khalf == 0) { const float m1 = mg[0], l1 = mg[1]; const float M = fmaxf(m, m1), c0 = __expf(m - M), c1 = __expf(m1 - M);
        mg[0] = M; mg[1] = l * c0 + l1 * c1;
#pragma unroll
        for (int i = 0; i < 16; ++i) { const f32x4 o1 = *(const f32x4*)(mg + 4 + 4 * i); *(f32x4*)(mg + 4 + 4 * i) = o[i] * c0 + o1 * c1; } }
    __syncthreads();
    float* OP = (float*)(AWS() + (lat ? WS_APL : WS_APC)); float* MLp = (float*)(AWS() + (lat ? WS_APL + APL_ML : WS_APC + APC_ML));
    const int NS = lat ? 7 : 2; const size_t tb = lat ? (size_t)(base - TCTX) : (size_t)base;
    for (int pr = wave * 32; pr < wave * 32 + 32; ++pr) { const int qq = pr & 127, hd = kvh * 2 + (pr >> 7);
        const size_t idx = ((tb + qb * 128 + qq) * 4 + hd) * NS + kt; const float* src = (const float*)lds + pr * 68;
        OP[idx * 64 + lane] = src[4 + lane];
        if (lane < 2) MLp[idx * 2 + lane] = src[lane]; }
}

typedef short hbf16x8 __attribute__((ext_vector_type(8)));
typedef float f32x16 __attribute__((ext_vector_type(16)));
constexpr int HY_FIL = 0, HY_Z = 32768, HY_XG = 49152, HY_ZERO = 65536;
template <int ORDER>
__device__ __forceinline__ void hyena_mfma_item(int li, int lat, int cq, int sgp, unsigned char* lds, int tid, int lane, int wave) {
    const int L = lat ? 1024 : 256, T = L >> 5, c0 = cq * 4;
    const float* Hk = (const float*)(AWS() + WS_HK + (size_t)li * HK_LAYER + (lat ? HK1024_OFF : 0)) + (size_t)ORDER * (2 * L - 1) * 256 + c0;
    const bf16* U = (const bf16*)(AWS() + WS_UA); bf16* Z1T = (bf16*)(AWS() + WS_Z1);
    const float* cw = INP(21) + li * 3 * 768; const float* cb = INP(22) + li * 768;
    bf16* FIL = (bf16*)(lds + HY_FIL); bf16* Zs = (bf16*)(lds + HY_Z); bf16* XG = (bf16*)(lds + HY_XG);
    __syncthreads();
    for (int lam = tid; lam < 2 * L - 1; lam += NTHR) {
        const f32x4 f = *(const f32x4*)(Hk + (size_t)lam * 256); const int x = 2 * L - 2 - lam;
#pragma unroll
        for (int ch = 0; ch < 4; ++ch) { const bf16 v = (bf16)f2bf(f[ch]); FIL[(ch * 2 + 0) * 2048 + x] = v; if (x >= 1) FIL[(ch * 2 + 1) * 2048 + x - 1] = v; }
    }
    if (tid < 8) ((unsigned*)(lds + HY_ZERO))[tid] = 0u;
    const int cz = c0, cg = 256 * (ORDER + 1) + c0;
    float wz[3][4], bz[4], wg[3][4], bg[4];
#pragma unroll
    for (int ch = 0; ch < 4; ++ch) { bz[ch] = cb[cz + ch]; bg[ch] = cb[cg + ch];
#pragma unroll
        for (int i = 0; i < 3; ++i) { wz[i][ch] = cw[i * 768 + cz + ch]; wg[i][ch] = cw[i * 768 + cg + ch]; } }
#pragma unroll
    for (int q = 0; q < 4; ++q) {
        const int p = tid + NTHR * q, sg2 = p >> 10, t = p & 1023, pos = t & (L - 1);
        const size_t tok = (size_t)(lat ? TCTX : 0) + (size_t)(sgp * 2 + sg2) * 1024 + t;
        const bf16* ur = U + tok * DINP + U_HY;
        const bool hasl = pos > 0, hasr = pos < L - 1;
        const u16x4 g0 = *(const u16x4*)(ur + cg), gl = hasl ? *(const u16x4*)(ur + cg - DINP) : (u16x4){0, 0, 0, 0}, gr = hasr ? *(const u16x4*)(ur + cg + DINP) : (u16x4){0, 0, 0, 0};
        u16x4 z0 = (u16x4){0, 0, 0, 0}, zl = z0, zr = z0;
        if (ORDER == 0) { z0 = *(const u16x4*)(ur + cz); if (hasl) zl = *(const u16x4*)(ur + cz - DINP); if (hasr) zr = *(const u16x4*)(ur + cz + DINP); }
#pragma unroll
        for (int ch = 0; ch < 4; ++ch) {
            const float gv = bg[ch] + wg[0][ch] * bf2f(gl[ch]) + wg[1][ch] * bf2f(g0[ch]) + wg[2][ch] * bf2f(gr[ch]);
            XG[(ch * 2 + sg2) * 1024 + t] = (bf16)f2bf(gv);
            bf16 zv;
            if (ORDER == 0) zv = (bf16)f2bf(bz[ch] + wz[0][ch] * bf2f(zl[ch]) + wz[1][ch] * bf2f(z0[ch]) + wz[2][ch] * bf2f(zr[ch]));
            else zv = Z1T[(size_t)(c0 + ch) * TT + tok];
            Zs[(ch * 2 + sg2) * 1024 + t] = zv;
        }
    }
    __syncthreads();
    const int chl = wave & 3, sg2 = wave >> 2;
    const int a = lane & 31, hh = lane >> 5, icol = lat ? a : (a & 7);
    const int par = (L - 1 - a) & 1;
    const LAS unsigned char* filb = (const LAS unsigned char*)lds + HY_FIL + (chl * 2 + par) * 4096 + 2 * ((L - 1) - a + 8 * hh - par);
    const LAS unsigned char* zb = (const LAS unsigned char*)lds + HY_Z + (chl * 2 + sg2) * 2048 + 2 * (32 * a + 8 * hh);
    const LAS unsigned char* zero = (const LAS unsigned char*)lds + HY_ZERO;
    f32x16 acc;
#pragma unroll
    for (int i = 0; i < 16; ++i) acc[i] = 0.f;
    for (int d = -(T - 1); d <= T - 1; ++d) {
        const int j = icol - d; const bool ok = (j >= 0) && (j < T);
#pragma unroll
        for (int kap = 0; kap < 2; ++kap) {
            const LAS unsigned* fp = (const LAS unsigned*)(filb + 2 * (16 * kap - 32 * d));
            u32x4 av; av.x = fp[0]; av.y = fp[1]; av.z = fp[2]; av.w = fp[3];
            const u32x4 bv = *(const LAS u32x4*)(ok ? zb + 2 * (16 * kap - 32 * d) : zero);
            acc = __builtin_amdgcn_mfma_f32_32x32x16_bf16(__builtin_bit_cast(hbf16x8, av), __builtin_bit_cast(hbf16x8, bv), acc, 0, 0, 0);
        }
    }
    const size_t tb = (size_t)(lat ? TCTX : 0) + (size_t)(sgp * 2 + sg2) * 1024;
    const bf16* xg = XG + (chl * 2 + sg2) * 1024 + 32 * a + 4 * hh;
#pragma unroll
    for (int g = 0; g < 4; ++g) {
        const u16x4 gq = *(const u16x4*)(xg + 8 * g);
        const float y0 = acc[4 * g + 0] * bf2f(gq.x), y1 = acc[4 * g + 1] * bf2f(gq.y), y2 = acc[4 * g + 2] * bf2f(gq.z), y3 = acc[4 * g + 3] * bf2f(gq.w);
        const size_t t = tb + 32 * a + 8 * g + 4 * hh;
        if (ORDER == 0) { u32x2 o; o.x = pk2(y0, y1); o.y = pk2(y2, y3); *(u32x2*)(Z1T + (size_t)(c0 + chl) * TT + t) = o; }
        else { bf16* ym = (bf16*)(AWS() + WS_YMIX) + t * D + 256 + c0 + chl; ym[0] = (bf16)f2bf(y0); ym[D] = (bf16)f2bf(y1); ym[2 * D] = (bf16)f2bf(y2); ym[3 * D] = (bf16)f2bf(y3); }
    }
}

__device__ __forceinline__ void finalize_token(int li, int tok, int lane) {
    const bf16* ur = (const bf16*)(AWS() + WS_UA) + (size_t)tok * DINP;
    bf16* ym = (bf16*)(AWS() + WS_YMIX) + (size_t)tok * D;
    const float* YS = (const float*)(AWS() + WS_YS); const float* YR = (const float*)(AWS() + WS_YR); const bf16* XBC = (const bf16*)(AWS() + WS_XBC);
    const int ch0 = lane * 4, hd = lane >> 4;
    {
        const f32x4 yf = *(const f32x4*)(YS + (size_t)tok * 256 + ch0), yb = *(const f32x4*)(YS + ((size_t)TT + tok) * 256 + ch0);
        const u16x4 xw = *(const u16x4*)(XBC + (size_t)tok * 768 + ch0); const f32x4 xs = (f32x4){bf2f(xw.x), bf2f(xw.y), bf2f(xw.z), bf2f(xw.w)};
        const u16x4 zw = *(const u16x4*)(ur + U_Z + ch0);
        const float dsk = INP(19)[li * 4 + hd];
        f32x4 y = yf + yb + xs * dsk;
        y.x *= siluf(bf2f(zw.x)); y.y *= siluf(bf2f(zw.y)); y.z *= siluf(bf2f(zw.z)); y.w *= siluf(bf2f(zw.w));
        const float ss = wave_sum((y.x * y.x + y.y * y.y) + (y.z * y.z + y.w * y.w));
        const float rstd = rsqrtf(ss * (1.0f / 256.0f) + EPS);
        const f32x4 nw = *(const f32x4*)(INP(20) + li * 256 + ch0);
        y = y * rstd * nw;
        u32x2 o; o.x = pk2(y.x, y.y); o.y = pk2(y.z, y.w); *(u32x2*)(ym + ch0) = o;
    }
    {
        const f32x4 yf = *(const f32x4*)(YR + (size_t)tok * 256 + ch0), yb = *(const f32x4*)(YR + ((size_t)TT + tok) * 256 + ch0);
        f32x4 y = yf + yb;
        float s = (y.x + y.y) + (y.z + y.w);
        s += __shfl_xor(s, 1); s += __shfl_xor(s, 2); s += __shfl_xor(s, 4); s += __shfl_xor(s, 8);
        const float mu = s * (1.0f / 64.0f);
        y = y - mu;
        float q = (y.x * y.x + y.y * y.y) + (y.z * y.z + y.w * y.w);
        q += __shfl_xor(q, 1); q += __shfl_xor(q, 2); q += __shfl_xor(q, 4); q += __shfl_xor(q, 8);
        const float rstd = rsqrtf(q * (1.0f / 64.0f) + EPS);
        const f32x4 gw = *(const f32x4*)(INP(31) + li * 256 + ch0);
        const u16x4 gg = *(const u16x4*)(ur + U_RET + 768 + ch0);
        y = y * rstd * gw;
        y.x *= siluf(bf2f(gg.x)); y.y *= siluf(bf2f(gg.y)); y.z *= siluf(bf2f(gg.z)); y.w *= siluf(bf2f(gg.w));
        u32x2 o; o.x = pk2(y.x, y.y); o.y = pk2(y.z, y.w); *(u32x2*)(ym + 512 + ch0) = o;
    }
    {
        const bool lat = tok >= TCTX;
        const float* OP = (const float*)(AWS() + (lat ? WS_APL : WS_APC)); const float* MLp = (const float*)(AWS() + (lat ? WS_APL + APL_ML : WS_APC + APC_ML));
        const int NS = lat ? 7 : 2; const size_t tb = lat ? (size_t)(tok - TCTX) : (size_t)tok;
        const int qb = lat ? (((tok - TCTX) & 1023) >> 7) : 0;
#pragma unroll
        for (int h = 0; h < 4; ++h) {
            const size_t idx = (tb * 4 + h) * NS;
            float ms = -1e30f, ls = 0.f;
            const bool sv = lane < NS && !(lat && ((lane == 4 && qb == 0) || (lane == 6 && qb == 7)));
            if (sv) { const f32x2 t = *(const f32x2*)(MLp + (idx + lane) * 2); ms = t.x; ls = t.y; }
            const float sink = INP(34)[li * 4 + h];
            float M = ms;
#pragma unroll
            for (int o = 1; o < 8; o <<= 1) M = fmaxf(M, __shfl_xor(M, o));
            M = fmaxf(M, sink);
            const float w = sv ? __expf(ms - M) : 0.f;
            float den = w * ls;
#pragma unroll
            for (int o = 1; o < 8; o <<= 1) den += __shfl_xor(den, o);
            den += __expf(sink - M);
            den = __shfl(den, 0);
            float ov = 0.f;
            for (int s = 0; s < NS; ++s) { const float ws_ = __shfl(w, s); if (ws_ != 0.f) ov += ws_ * OP[(idx + s) * 64 + lane]; }
            ym[768 + h * 64 + lane] = (bf16)f2bf(ov / den);
        }
    }
}


#define XB_TMO      128
#define XB_XCNT(j)  (256  + 64 * (j))
#define XB_XSUB(j)  (1280 + 64 * (j))
#define XB_XGEN(j)  (2304 + 64 * (j))
#define XB_TOP      3328
#define XB_TOPGEN   3392
#define XCD_BAR_WORDS 3456
#define XB_SPIN_CAP (1u << 18)
__device__ __forceinline__ unsigned xb_ld(unsigned* p)              { return __hip_atomic_load(p, __ATOMIC_RELAXED, __HIP_MEMORY_SCOPE_AGENT); }
__device__ __forceinline__ unsigned xb_add(unsigned* p, unsigned v) { return __hip_atomic_fetch_add(p, v, __ATOMIC_RELAXED, __HIP_MEMORY_SCOPE_AGENT); }
__device__ __forceinline__ unsigned xb_xcc_id() { return (unsigned)__builtin_amdgcn_s_getreg((3 << 11) | 20) & 0xFu; }
#define XB_SPIN(cond, bar) do { unsigned _sp = 0; while (cond) { __builtin_amdgcn_s_sleep(1); \
    if ((++_sp & 255u) == 0u) { if (xb_ld(&(bar)[XB_TMO])) break; if (_sp > XB_SPIN_CAP) { atomicAdd(&(bar)[XB_TMO], 1u); break; } } } } while (0)
__device__ __forceinline__ void xcd_barrier_complete(unsigned* bar, unsigned x, unsigned& nloc, unsigned& nx) {
    const unsigned G = gridDim.x * gridDim.y * gridDim.z;
    unsigned sum, cnt, mine, sp = 0u;
    for (;;) {
        sum = 0u; cnt = 0u; mine = 0u;
#pragma unroll
        for (unsigned j = 0; j < 16; ++j) { const unsigned c = xb_ld(&bar[XB_XCNT(j)]); sum += c; cnt += (c > 0u) ? 1u : 0u; mine = (j == x) ? c : mine; }
        if (sum == G) break;
        __builtin_amdgcn_s_sleep(1);
        if ((++sp & 255u) == 0u) { if (xb_ld(&bar[XB_TMO])) break; if (sp > XB_SPIN_CAP) { atomicAdd(&bar[XB_TMO], 1u); break; } }
    }
    nloc = mine > 0u ? mine : 1u; nx = cnt > 0u ? cnt : 1u;
}
__device__ __forceinline__ void xcd_barrier(unsigned* bar, volatile LAS unsigned* st) {
    asm volatile("s_waitcnt vmcnt(0)" ::: "memory");
    __syncthreads();
    if (threadIdx.x == 0) {
        const unsigned x = xb_xcc_id();
        __builtin_amdgcn_s_waitcnt(0);
        unsigned nloc = st[0], nx = st[1];
        if (nloc == 0u) { xcd_barrier_complete(bar, x, nloc, nx); st[0] = nloc; st[1] = nx; }
        const unsigned old = xb_add(&bar[XB_XSUB(x)], 1u);
        const unsigned gen = old / nloc;
        if (old + 1u == (gen + 1u) * nloc) {
            __builtin_amdgcn_fence(__ATOMIC_RELEASE, "agent");
            asm volatile("s_waitcnt vmcnt(0)" ::: "memory");
            const unsigned og = xb_add(&bar[XB_TOP], 1u);
            const unsigned tg = og / nx;
            if (og + 1u == (tg + 1u) * nx) xb_add(&bar[XB_TOPGEN], 1u);
            else XB_SPIN(xb_ld(&bar[XB_TOPGEN]) == tg, bar);
            __builtin_amdgcn_fence(__ATOMIC_ACQUIRE, "agent");
            xb_add(&bar[XB_XGEN(x)], 1u);
            asm volatile("s_waitcnt vmcnt(0)" ::: "memory");
        } else {
            XB_SPIN(xb_ld(&bar[XB_XGEN(x)]) == gen, bar);
            __builtin_amdgcn_fence(__ATOMIC_ACQUIRE, "agent");
            asm volatile("s_waitcnt vmcnt(0)" ::: "memory");
        }
    }
    __syncthreads();
}

__device__ __forceinline__ int dq_next(unsigned* ctr, volatile int* slot, int tid) {
    __syncthreads();
    if (tid == 0) *slot = (int)__hip_atomic_fetch_add(ctr, 1u, __ATOMIC_RELAXED, __HIP_MEMORY_SCOPE_AGENT);
    __syncthreads();
    return *slot;
}

__global__ void __launch_bounds__(NTHR, 2) mk_fwd(Args a) {
    extern __shared__ __attribute__((aligned(16))) unsigned char lds[];
    const int ph_hi = karg_i32(8 * 37 + 4);
    if (threadIdx.x < 64) ((volatile LAS unsigned*)((LAS unsigned char*)lds + 131072))[threadIdx.x] = 0u;
    __syncthreads();
    if (!MK_MULTI && threadIdx.x == 0) (void)xb_add((unsigned*)(AWS() + WS_CTL) + CW_BAR + XB_XCNT(xb_xcc_id()), 1u);
    for (int ph = karg_i32(8 * 37); ph < ph_hi; ++ph) {
        int nrep = 1;
        if (MK_REP) { const int k = (ph - 1) % 12;
            if (ph == 0) nrep += REP(0);
            else if (ph < NPHASE) nrep += (k == 0 || k == 3 || k == 9) ? REP(1) : (k == 1 || k == 10) ? REP(2) : (k == 2 || k == 8 || k == 11) ? REP(3) : k == 4 ? REP(4) : k == 5 ? REP(5) : k == 6 ? REP(6) : REP(7); }
        for (int rep = 0; rep < nrep; ++rep) {
        int tid = threadIdx.x; asm volatile("" : "+v"(tid));
        int G = gridDim.x, bid = blockIdx.x; asm volatile("" : "+s"(G), "+s"(bid));
        const int lane = tid & 63, wave = __builtin_amdgcn_readfirstlane(tid >> 6);
        const int gw = bid * NWAVES + wave, NGW = G * NWAVES;
        unsigned* ctl = (unsigned*)(AWS() + WS_CTL);
        volatile int* qslot = (volatile int*)(lds + 131072 + 64);
        float* xbuf = AOUT() + O_Y;
        if (rep) xcd_barrier((unsigned*)(AWS() + WS_CTL) + CW_BAR, (volatile LAS unsigned*)((LAS unsigned char*)lds + 131072 + 128));
        if (ph == 0) {
            if (EN(0)) phase0(lds, tid, lane, wave, G);
        } else if (ph == NPHASE) {
            float* o = AOUT();
#define ZERO_OUT(i, lo, hi) if (!((MK_KEEP >> (i)) & 1)) for (size_t e = (size_t)(lo) + (size_t)bid * NTHR + tid; e < (size_t)(hi); e += (size_t)G * NTHR) o[e] = 0.f;
            ZERO_OUT(0, 0, 8388608) ZERO_OUT(1, 8388608, 10485760) ZERO_OUT(2, 10485760, 12582912) ZERO_OUT(3, 12582912, 14680064) ZERO_OUT(4, 14680064, 18874368) ZERO_OUT(5, 18874368, 20971520)
        } else {
            const int li = (ph - 1) / 12, k = (ph - 1) % 12;
            const float* modl = (const float*)(AWS() + WS_MOD) + (size_t)li * 3 * 9216;
            unsigned char* wl = AWS() + WS_W + (size_t)li * W_LAYER;
            const bool first = (li == 0 && k <= 2);
            const float* xc = first ? INP(0) : xbuf;
            const float* xl = first ? INP(1) - (size_t)TCTX * D : xbuf;
            if (k == 0 || k == 3 || k == 9) {
                const int p = k == 0 ? 0 : (k == 3 ? 1 : 2);
                if (EN(1)) prep_phase(xc, xl, INP(10) + (li * 3 + p) * 1024, modl, p, (bf16*)(AWS() + WS_H), gw, NGW, lane);
            } else if (k == 1 || k == 10) {
                pg8::Gemm g{(const bf16*)(AWS() + WS_H), (const bf16*)(wl + (k == 1 ? W_IN0 : W_IN1)), TT, 2 * DFF, D};
                pg8::StaticOrder S; S.init(TT, 2 * DFF, G, bid);
                pg8::EpiSwiglu E{(bf16*)(AWS() + WS_UA), DFF};
                if (EN(2)) pg8::gemm_phase<pg8::EpiSwiglu, pg8::StaticOrder, true, true>((LAS unsigned char*)lds, g, S, E, tid);
            } else if (k == 2 || k == 8 || k == 11) {
                const bool mix = (k == 8);
                pg8::Gemm g{(const bf16*)(AWS() + (mix ? WS_YMIX : WS_UA)), (const bf16*)(wl + (mix ? W_MO : (k == 2 ? W_OUT0 : W_OUT1))), TT, D, mix ? D : DFF};
                pg8::StaticOrder S; S.init(TT, D, G, bid);
                const int gi = k == 2 ? 2 : (k == 8 ? 5 : 8);
                pg8::EpiResid E{xc, xl, (rep + 1 < nrep) ? (float*)(AWS() + WS_XBC) : xbuf, modl + gi * 1024, mix ? 1.0f : 0.5f};
                if (EN(3)) pg8::gemm_phase<pg8::EpiResid, pg8::StaticOrder, true, true>((LAS unsigned char*)lds, g, S, E, tid);
            } else if (k == 4) {
                pg8::Gemm g{(const bf16*)(AWS() + WS_H), (const bf16*)(wl + W_MI), TT, DINP, D};
                pg8::StaticOrder S; S.init(TT, DINP, G, bid);
                pg8::EpiBf16 E{(bf16*)(AWS() + WS_UA), DINP};
                if (EN(4)) pg8::gemm_phase<pg8::EpiBf16, pg8::StaticOrder, true, true>((LAS unsigned char*)lds, g, S, E, tid);
            } else if (k == 5) {
                if (EN(5)) m1_phase(li, gw, NGW, lane);
            } else if (k == 6) {
                for (;;) {
                    int it = dq_next(ctl + ph + 32 * rep, qslot, threadIdx.x);
                    if (it >= 1072) break;
                    int tid = threadIdx.x, li = (ph - 1) / 12; asm volatile("" : "+v"(tid)); asm volatile("" : "+s"(li));
                    const int lane = tid & 63, wave = __builtin_amdgcn_readfirstlane(tid >> 6);
                    if (it < 8) { for (int rr = 0; rr <= REP(8); ++rr) cscan_item<128, true>(li, 32 + (it >> 2), it & 3, lds, tid, lane, wave); continue; } it -= 8;
                    if (it < 8) { for (int rr = 0; rr <= REP(9); ++rr) cscan_item<64, false>(li, 32 + (it >> 2), it & 3, lds, tid, lane, wave); continue; } it -= 8;
                    if (it < 64) { if (EN(9)) hyena_mfma_item<0>(li, 1, it, 0, lds, tid, lane, wave); continue; } it -= 64;
                    if (it < 224) { const int kt = it % 7, r = it / 7, qb = r & 7, kvh = (r >> 3) & 1, b = r >> 4;
                        if ((kt == 4 && qb == 0) || (kt == 6 && qb == 7)) continue;
                        for (int rr = 0; rr <= REP(10); ++rr) attn_item(li, 32 + b, kvh, qb, kt, lds, tid, lane, wave); continue; } it -= 224;
                    if (it < 128) { for (int rr = 0; rr <= REP(8); ++rr) cscan_item<128, true>(li, it >> 2, it & 3, lds, tid, lane, wave); continue; } it -= 128;
                    if (it < 128) { for (int rr = 0; rr <= REP(9); ++rr) cscan_item<64, false>(li, it >> 2, it & 3, lds, tid, lane, wave); continue; } it -= 128;
                    if (it < 256) { for (int rr = 0; rr <= REP(10); ++rr) attn_item(li, it >> 3, (it >> 2) & 1, (it >> 1) & 1, it & 1, lds, tid, lane, wave); continue; } it -= 256;
                    if (EN(9)) hyena_mfma_item<0>(li, 0, it >> 2, it & 3, lds, tid, lane, wave);
                }
            } else if (k == 7) {
                for (;;) {
                    int it = dq_next(ctl + ph + 32 * rep, qslot, threadIdx.x);
                    if (it >= 1600) break;
                    int tid = threadIdx.x, li = (ph - 1) / 12; asm volatile("" : "+v"(tid)); asm volatile("" : "+s"(li));
                    const int lane = tid & 63, wave = __builtin_amdgcn_readfirstlane(tid >> 6);
                    if (it < 64) { if (EN(10)) hyena_mfma_item<1>(li, 1, it, 0, lds, tid, lane, wave); continue; } it -= 64;
                    if (it < 256) { if (EN(10)) hyena_mfma_item<1>(li, 0, it >> 2, it & 3, lds, tid, lane, wave); continue; } it -= 256;
                    for (int rr = 0; rr <= REP(12); ++rr) finalize_token(li, it * 8 + wave, lane);
                }
            }
        }
        }
        if (ph + 1 < ph_hi) {
            if (ph == 0) cg::this_grid().sync();
            else xcd_barrier((unsigned*)(AWS() + WS_CTL) + CW_BAR, (volatile LAS unsigned*)((LAS unsigned char*)lds + 131072 + 128));
        }
    }

}

extern "C" void kernel_launch(void* const* d_in, const int* in_sizes, int n_in, void* d_out, int out_size, void* d_ws, size_t ws_size, hipStream_t stream) {
    static int grid = 0;
    if (grid == 0) {
        if (n_in != 35 || ws_size < WS_END) { fprintf(stderr, "kernel_launch: unexpected n_in %d / ws %zu\n", n_in, ws_size); grid = -1; return; }
        int dev = 0, cus = 0, per_cu = 0;
        hipGetDevice(&dev);
        hipDeviceGetAttribute(&cus, hipDeviceAttributeMultiprocessorCount, dev);
        if (hipFuncSetAttribute((const void*)mk_fwd, hipFuncAttributeMaxDynamicSharedMemorySize, LDS_BYTES) != hipSuccess) { fprintf(stderr, "kernel_launch: hipFuncSetAttribute failed\n"); grid = -1; return; }
        if (hipOccupancyMaxActiveBlocksPerMultiprocessor(&per_cu, (const void*)mk_fwd, NTHR, LDS_BYTES) != hipSuccess || per_cu < 1) { fprintf(stderr, "kernel_launch: occupancy query says %d\n", per_cu); per_cu = 1; }
        (void)hipGetLastError();
        if (per_cu > 1) per_cu = 1;
        grid = cus * per_cu;
    }
    if (grid < 0) return;
    hipMemsetAsync((char*)d_ws + WS_CTL, 0, CTL_ZERO_BYTES, stream);
    Args a{};
    for (int i = 0; i < 35; ++i) a.in[i] = (const float*)d_in[i];
    a.out = (float*)d_out; a.ws = (unsigned char*)d_ws;
#if MK_MULTI
    for (int ph = 0; ph < NPHASE; ++ph) { a.ph_lo = ph; a.ph_hi = ph + 1; hipLaunchKernelGGL(mk_fwd, dim3(grid), dim3(NTHR), LDS_BYTES, stream, a); }
#else
    a.ph_lo = 0; a.ph_hi = NPHASE + (MK_KEEP != 0x3F ? 1 : 0);
    void* args[] = {&a};
    hipError_t e = hipLaunchCooperativeKernel((const void*)mk_fwd, dim3(grid), dim3(NTHR), args, LDS_BYTES, stream);
    if (e != hipSuccess) fprintf(stderr, "cooperative launch failed: %s (grid %d)\n", hipGetErrorString(e), grid);
#endif
}
```

```cpp
#include <hip/hip_runtime.h>
#include <hip/hip_cooperative_groups.h>
#include <cstdio>
#include <cstdint>
namespace cg = cooperative_groups;

#ifndef MK_EN
#define MK_EN 0xFFFF
#endif
#define EN(b) ((MK_EN >> (b)) & 1)
#ifndef MK_KEEP
#define MK_KEEP 0x3F
#endif
#ifndef MK_REP
#define MK_REP 0
#endif
#define REP(b) ((MK_REP >> (b)) & 1)
#ifndef MK_MULTI
#define MK_MULTI 0
#endif

#define GAS __attribute__((address_space(1)))
#define LAS __attribute__((address_space(3)))
typedef unsigned short bf16;
typedef float f32x4 __attribute__((ext_vector_type(4)));
typedef float f32x2 __attribute__((ext_vector_type(2)));
typedef unsigned u32x4 __attribute__((ext_vector_type(4)));
typedef unsigned u32x2 __attribute__((ext_vector_type(2)));
typedef unsigned short u16x4 __attribute__((ext_vector_type(4)));

namespace pg8 {
#define PG8_LAS __attribute__((address_space(3)))
typedef unsigned short bf16_t;
typedef short bf16x8 __attribute__((ext_vector_type(8)));
constexpr int BM = 256, BK = 64, HALF = 128, HTB = HALF * BK * 2, STAGE_BYTES = 8 * HTB, NXCD = 8, WGM = 8;

__host__ __device__ __forceinline__ int lds_byte(int r, int c) { const int st = (r >> 4) * 2 + (c >> 5), rr = r & 15, cc = c & 31, ob = rr * 64 + cc * 2; return st * 1024 + (ob ^ (((ob >> 9) & 1) << 5)); }
__host__ __device__ __forceinline__ void stage_rc(int b, int& R, int& C) { const int st = b / 1024, sb = b % 1024, swz = sb ^ (((sb >> 9) & 1) << 5); R = (st >> 1) * 16 + swz / 64; C = (st & 1) * 32 + (swz % 64) / 2; }
__host__ __device__ __forceinline__ int perm32(int rho) { const int n = rho >> 4, i = rho & 15; return 8 * (i >> 2) + 4 * n + (i & 3); }

struct Unit { int pm, pn; };
struct Gemm { const bf16_t* A; const bf16_t* Bt; int M, N, K; };

struct StaticOrder {
    int nM, nN, nwg, G, c;
    __host__ __device__ void init(int M, int N, int G_, int c_) { nM = M / BM; nN = N / BM; nwg = nM * nN; G = G_; c = c_; }
    __host__ __device__ bool next(int i, Unit& u) const {
        const long L = (long)i * G + c; if (L >= nwg) return false;
        int wgid = (int)L; { const int q = nwg / NXCD, r = nwg % NXCD, xcd = wgid % NXCD, off = wgid / NXCD; wgid = (xcd < r ? xcd * (q + 1) : r * (q + 1) + (xcd - r) * q) + off; }
        const int nig = WGM * nN, gid = wgid / nig, fm = gid * WGM, gsz = (nM - fm) < WGM ? (nM - fm) : WGM;
        u.pm = fm + ((wgid % nig) % gsz); u.pn = (wgid % nig) / gsz; return true;
    }
    __device__ __forceinline__ void a_ready(const Unit&) const {}
    __device__ __forceinline__ void done(const Unit&) const {}
};

__device__ __forceinline__ unsigned cvt_pk_bf16(float lo, float hi) { unsigned r; asm volatile("v_cvt_pk_bf16_f32 %0, %1, %2" : "=v"(r) : "v"(lo), "v"(hi)); return r; }
__device__ __forceinline__ float silu_f(float v) { return v * __builtin_amdgcn_rcpf(1.0f + __expf(-v)); }

struct EpiSwiglu {
    static constexpr bool PERM = true, AFTER_DRAIN = false;
    bf16_t* O; int ldc;
    __device__ __forceinline__ void operator()(const f32x4 (&acc)[2][2][4][2], const Unit& u, int wr, int wc, int fr, int fq) const {
        const int row0 = u.pm * BM + wr * 64 + fr, col0 = u.pn * HALF + wc * 32 + 8 * fq;
#pragma unroll
        for (int ai = 0; ai < 2; ++ai)
#pragma unroll
            for (int m = 0; m < 4; ++m) { bf16_t* rowp = O + (size_t)(row0 + ai * HALF + m * 16) * ldc + col0;
                const f32x4 g0 = acc[ai][0][m][0], g1 = acc[ai][0][m][1], u0 = acc[ai][1][m][0], u1 = acc[ai][1][m][1];
                u32x4 w;
                w.x = cvt_pk_bf16(silu_f(g0[0]) * u0[0], silu_f(g0[1]) * u0[1]); w.y = cvt_pk_bf16(silu_f(g0[2]) * u0[2], silu_f(g0[3]) * u0[3]);
                w.z = cvt_pk_bf16(silu_f(g1[0]) * u1[0], silu_f(g1[1]) * u1[1]); w.w = cvt_pk_bf16(silu_f(g1[2]) * u1[2], silu_f(g1[3]) * u1[3]);
                *(u32x4*)rowp = w; }
    }
};
struct EpiBf16 {
    static constexpr bool PERM = true, AFTER_DRAIN = false;
    bf16_t* O; int ldc;
    __device__ __forceinline__ void operator()(const f32x4 (&acc)[2][2][4][2], const Unit& u, int wr, int wc, int fr, int fq) const {
        const int row0 = u.pm * BM + wr * 64 + fr, col0 = u.pn * BM + wc * 32 + 8 * fq;
#pragma unroll
        for (int ai = 0; ai < 2; ++ai)
#pragma unroll
            for (int m = 0; m < 4; ++m) { bf16_t* rowp = O + (size_t)(row0 + ai * HALF + m * 16) * ldc + col0;
#pragma unroll
                for (int bj = 0; bj < 2; ++bj) { const f32x4 v0 = acc[ai][bj][m][0], v1 = acc[ai][bj][m][1];
                    u32x4 w; w.x = cvt_pk_bf16(v0[0], v0[1]); w.y = cvt_pk_bf16(v0[2], v0[3]); w.z = cvt_pk_bf16(v1[0], v1[1]); w.w = cvt_pk_bf16(v1[2], v1[3]);
                    *(u32x4*)(rowp + bj * HALF) = w; } }
    }
};
struct EpiResid {
    static constexpr bool PERM = false, AFTER_DRAIN = false;
    const float* xin_ctx; const float* xin_lat; float* out; const float* gate; float scale;
    __device__ __forceinline__ void operator()(const f32x4 (&acc)[2][2][4][2], const Unit& u, int wr, int wc, int fr, int fq) const {
        const int row0 = u.pm * BM + wr * 64 + fr, col0 = u.pn * BM + wc * 32 + 4 * fq;
        const int cidx = u.pm < 32 ? 0 : 1 + ((u.pm - 32) >> 2);
        const float* xin = u.pm < 32 ? xin_ctx : xin_lat;
        const float* gp = gate + cidx * 9216 + col0;
        f32x4 gv[2][2];
#pragma unroll
        for (int bj = 0; bj < 2; ++bj)
#pragma unroll
            for (int n = 0; n < 2; ++n) gv[bj][n] = *(const f32x4*)(gp + bj * HALF + n * 16) * scale;
#pragma unroll
        for (int ai = 0; ai < 2; ++ai)
#pragma unroll
            for (int m = 0; m < 4; ++m) { const size_t off = (size_t)(row0 + ai * HALF + m * 16) * 1024 + col0;
#pragma unroll
                for (int bj = 0; bj < 2; ++bj)
#pragma unroll
                    for (int n = 0; n < 2; ++n) { const f32x4 xv = *(const f32x4*)(xin + off + bj * HALF + n * 16);
                        *(f32x4*)(out + off + bj * HALF + n * 16) = xv + gv[bj][n] * acc[ai][bj][m][n]; } }
    }
};

template <class Epi, class Sched, bool ALIGN_EPI = false, bool SP2 = false>
__device__ __forceinline__ void gemm_phase(PG8_LAS unsigned char* lds, const Gemm g, const Sched& S, const Epi& E, const int tid) {
    const int wid = __builtin_amdgcn_readfirstlane(tid >> 6), lane = tid & 63, wr = wid >> 2, wc = wid & 3, fr = lane & 15, fq = lane >> 4;
    const int K = g.K, nt = K / BK;
    unsigned voffA[2], voffB[2];
#pragma unroll
    for (int i = 0; i < 2; ++i) { int R, C; stage_rc(tid * 16 + i * 8192, R, C); const int Rb = Epi::PERM ? ((R & ~31) + perm32(R & 31)) : R;
        voffA[i] = (unsigned)(R * K + C) * 2u; voffB[i] = (unsigned)(Rb * K + C) * 2u; }
    const size_t kstep = (size_t)(BK * 2);
    const size_t hstep = (size_t)HALF * K * 2;
    const size_t tstep = 2 * hstep;
    const unsigned ldsw = (unsigned)wid * 1024u;
    const int aoff = lds_byte(wr * 64 + fr, fq * 8), boff = lds_byte(wc * 32 + fr, fq * 8);
#define PG8_SA(b, h) (((b) * 2 + (h)) * HTB)
#define PG8_SB(b, h) ((4 + (b) * 2 + (h)) * HTB)
#define PG8_STAGE(bufoff, gbase, voff) do { _Pragma("unroll") for (int _i = 0; _i < 2; ++_i) \
        __builtin_amdgcn_global_load_lds((const unsigned*)((const char*)(gbase) + (voff)[_i]), (PG8_LAS unsigned*)(lds + (bufoff) + ldsw + _i * 8192), 16, 0, 0); } while (0)
#define PG8_LDA(dst, b, h) do { _Pragma("unroll") for (int m = 0; m < 4; ++m) _Pragma("unroll") for (int k = 0; k < 2; ++k) dst[m][k] = *(const PG8_LAS bf16x8*)(lds + PG8_SA(b, h) + aoff + m * 2048 + k * 1024); } while (0)
#define PG8_LDB(dst, b, h) do { _Pragma("unroll") for (int n = 0; n < 2; ++n) _Pragma("unroll") for (int k = 0; k < 2; ++k) dst[n][k] = *(const PG8_LAS bf16x8*)(lds + PG8_SB(b, h) + boff + n * 2048 + k * 1024); } while (0)
#define PG8_MMA(ai, bj, At, Bt) do { __builtin_amdgcn_s_setprio(1); _Pragma("unroll") for (int m = 0; m < 4; ++m) _Pragma("unroll") for (int n = 0; n < 2; ++n) _Pragma("unroll") for (int k = 0; k < 2; ++k) \
        acc[ai][bj][m][n] = __builtin_amdgcn_mfma_f32_16x16x32_bf16(Bt[n][k], At[m][k], acc[ai][bj][m][n], 0, 0, 0); __builtin_amdgcn_s_setprio(0); } while (0)
#define PG8_WAIT_V(n) asm volatile("s_waitcnt vmcnt(" #n ")" ::: "memory")
#define PG8_WAIT_L(n) asm volatile("s_waitcnt lgkmcnt(" #n ")" ::: "memory")
#define PG8_BAR __builtin_amdgcn_s_barrier()
#define PG8_SCHED __builtin_amdgcn_sched_barrier(0)
    Unit cur, nxt; int ui = 0;
    if (!S.next(0, cur)) return;
    f32x4 acc[2][2][4][2];
#pragma unroll
    for (int a = 0; a < 2; ++a)
#pragma unroll
        for (int b = 0; b < 2; ++b)
#pragma unroll
            for (int m = 0; m < 4; ++m)
#pragma unroll
                for (int n = 0; n < 2; ++n) acc[a][b][m][n] = (f32x4){0.f, 0.f, 0.f, 0.f};
    bf16x8 At[4][2], B0[2][2], B1[2][2];
    const char* cA = (const char*)g.A + (size_t)cur.pm * tstep; const char* cB = (const char*)g.Bt + (size_t)cur.pn * tstep;
    S.a_ready(cur);
    if constexpr (SP2) {
        PG8_STAGE(PG8_SB(0, 0), cB, voffB); PG8_STAGE(PG8_SB(0, 1), cB + hstep, voffB); PG8_STAGE(PG8_SA(0, 0), cA, voffA); PG8_STAGE(PG8_SA(0, 1), cA + hstep, voffA);
        if (wr == 1) PG8_BAR;
        PG8_WAIT_V(2); PG8_BAR;
        PG8_STAGE(PG8_SB(1, 0), cB + kstep, voffB); PG8_STAGE(PG8_SA(1, 0), cA + kstep, voffA); PG8_STAGE(PG8_SB(1, 1), cB + hstep + kstep, voffB);
        PG8_WAIT_V(6); PG8_BAR;
    } else {
        PG8_STAGE(PG8_SB(0, 0), cB, voffB); PG8_STAGE(PG8_SA(0, 0), cA, voffA); PG8_STAGE(PG8_SB(0, 1), cB + hstep, voffB); PG8_STAGE(PG8_SA(0, 1), cA + hstep, voffA);
        if (wr == 1) PG8_BAR;
        PG8_WAIT_V(4); PG8_BAR;
        PG8_STAGE(PG8_SB(1, 0), cB + kstep, voffB); PG8_STAGE(PG8_SA(1, 0), cA + kstep, voffA); PG8_STAGE(PG8_SB(1, 1), cB + hstep + kstep, voffB);
        PG8_WAIT_V(6); PG8_BAR;
    }
    for (;;) {
        const bool has_next = S.next(ui + 1, nxt);
        const char* nA = has_next ? (const char*)g.A + (size_t)nxt.pm * tstep : cA; const char* nB = has_next ? (const char*)g.Bt + (size_t)nxt.pn * tstep : cB;
        for (int t = 0; t < nt; t += 2) {
            const bool last = (t == nt - 2);
            const char* a1 = cA + (size_t)(t + 1) * kstep;
            const char* a2 = last ? nA : cA + (size_t)(t + 2) * kstep; const char* b2 = last ? nB : cB + (size_t)(t + 2) * kstep;
            const char* a3 = a2 + kstep; const char* b3 = b2 + kstep;
            if (last && has_next) S.a_ready(nxt);
            if constexpr (SP2) {
            PG8_LDB(B0, 0, 0); PG8_LDB(B1, 0, 1); PG8_SCHED; PG8_LDA(At, 0, 0); PG8_STAGE(PG8_SA(1, 1), a1 + hstep, voffA);
            PG8_WAIT_V(8); PG8_WAIT_L(0); PG8_BAR; PG8_MMA(0, 0, At, B0); PG8_MMA(0, 1, At, B1); PG8_BAR; PG8_SCHED;
            PG8_LDA(At, 0, 1); PG8_STAGE(PG8_SB(0, 0), b2, voffB); PG8_STAGE(PG8_SB(0, 1), b2 + hstep, voffB); PG8_STAGE(PG8_SA(0, 0), a2, voffA);
            PG8_WAIT_V(8); PG8_WAIT_L(0); PG8_BAR; PG8_MMA(1, 0, At, B0); PG8_MMA(1, 1, At, B1); PG8_BAR; PG8_SCHED;
            PG8_LDB(B0, 1, 0); PG8_LDB(B1, 1, 1); PG8_SCHED; PG8_LDA(At, 1, 0); PG8_STAGE(PG8_SA(0, 1), a2 + hstep, voffA);
            PG8_WAIT_V(8); PG8_WAIT_L(0); PG8_BAR; PG8_MMA(0, 0, At, B0); PG8_MMA(0, 1, At, B1); PG8_BAR; PG8_SCHED;
            PG8_LDA(At, 1, 1); PG8_STAGE(PG8_SB(1, 0), b3, voffB); PG8_STAGE(PG8_SB(1, 1), b3 + hstep, voffB); PG8_STAGE(PG8_SA(1, 0), a3, voffA);
            PG8_WAIT_V(8); PG8_WAIT_L(0); PG8_BAR; PG8_MMA(1, 0, At, B0); PG8_MMA(1, 1, At, B1); PG8_BAR; PG8_SCHED;
            } else {
            PG8_LDB(B0, 0, 0); PG8_SCHED; PG8_LDA(At, 0, 0); PG8_STAGE(PG8_SA(1, 1), a1 + hstep, voffA);
            PG8_WAIT_L(8); PG8_BAR; PG8_WAIT_L(0); PG8_MMA(0, 0, At, B0); PG8_BAR; PG8_SCHED;
            PG8_LDB(B1, 0, 1); PG8_STAGE(PG8_SB(0, 0), b2, voffB);
            PG8_BAR; PG8_WAIT_L(0); PG8_MMA(0, 1, At, B1); PG8_BAR;
            PG8_LDA(At, 0, 1); PG8_STAGE(PG8_SA(0, 0), a2, voffA);
            PG8_BAR; PG8_WAIT_L(0); PG8_MMA(1, 0, At, B0); PG8_BAR; PG8_SCHED;
            PG8_STAGE(PG8_SB(0, 1), b2 + hstep, voffB);
            PG8_WAIT_V(6); PG8_BAR; PG8_MMA(1, 1, At, B1); PG8_BAR;
            PG8_LDB(B0, 1, 0); PG8_SCHED; PG8_LDA(At, 1, 0); PG8_STAGE(PG8_SA(0, 1), a2 + hstep, voffA);
            PG8_WAIT_L(8); PG8_BAR; PG8_WAIT_L(0); PG8_MMA(0, 0, At, B0); PG8_BAR; PG8_SCHED;
            PG8_LDB(B1, 1, 1); PG8_STAGE(PG8_SB(1, 0), b3, voffB);
            PG8_BAR; PG8_WAIT_L(0); PG8_MMA(0, 1, At, B1); PG8_BAR;
            PG8_LDA(At, 1, 1); PG8_STAGE(PG8_SA(1, 0), a3, voffA);
            PG8_BAR; PG8_WAIT_L(0); PG8_MMA(1, 0, At, B0); PG8_BAR; PG8_SCHED;
            PG8_STAGE(PG8_SB(1, 1), b3 + hstep, voffB);
            PG8_WAIT_V(6); PG8_BAR; PG8_MMA(1, 1, At, B1); PG8_BAR;
            }
        }
        if constexpr (ALIGN_EPI) { if (wr == 0) PG8_BAR; }
        if constexpr (!Epi::AFTER_DRAIN) { E(acc, cur, wr, wc, fr, fq); S.done(cur); }
        if (!has_next) break;
#pragma unroll
        for (int a = 0; a < 2; ++a)
#pragma unroll
            for (int b = 0; b < 2; ++b)
#pragma unroll
                for (int m = 0; m < 4; ++m)
#pragma unroll
                    for (int n = 0; n < 2; ++n) acc[a][b][m][n] = (f32x4){0.f, 0.f, 0.f, 0.f};
        cur = nxt; cA = nA; cB = nB; ++ui;
        if constexpr (ALIGN_EPI) { if (wr == 1) PG8_BAR; }
    }
    PG8_WAIT_V(0);
    if constexpr (!ALIGN_EPI) { if (wr == 0) PG8_BAR; }
    PG8_BAR;
#undef PG8_SA
#undef PG8_SB
#undef PG8_STAGE
#undef PG8_LDA
#undef PG8_LDB
#undef PG8_MMA
#undef PG8_WAIT_V
#undef PG8_WAIT_L
#undef PG8_BAR
#undef PG8_SCHED
}
}

constexpr int NTHR = 512, NWAVES = 8;
constexpr int D = 1024, TCTX = 8192, TLAT = 2048, TT = 10240, DFF = 2816;
constexpr int DIN = 3336, DINP = 3584;
constexpr int U_Z = 0, U_XBC = 256, U_DT = 1024, U_HY = 1032, U_RET = 1800, U_ATT = 2824;
constexpr float EPS = 1e-6f;
constexpr int NPHASE = 25;

constexpr size_t MiB = 1u << 20;
constexpr size_t WS_CTL = 0, CTL_ZERO_BYTES = 65536;
constexpr int CW_BAR = 4096;
constexpr size_t WS_MOD = 1 * MiB;
constexpr size_t WS_HK = 2 * MiB, HK_LAYER = 6 * MiB, HK1024_OFF = 1310720;
constexpr size_t WS_W = 14 * MiB, W_LAYER = 42 * MiB;
constexpr size_t W_IN0 = 0, W_IN1 = 11 * MiB, W_OUT0 = 22 * MiB, W_OUT1 = 22 * MiB + 5767168, W_MI = 33 * MiB, W_MO = 40 * MiB;
constexpr size_t WS_H = 98 * MiB;
constexpr size_t WS_YMIX = 118 * MiB;
constexpr size_t WS_UA = 138 * MiB;
constexpr size_t WS_XBC = 208 * MiB;
constexpr size_t WS_SCAL = 223 * MiB;
constexpr size_t WS_QK = 238 * MiB;
constexpr size_t WS_YS = 253 * MiB;
constexpr size_t WS_YR = 273 * MiB;
constexpr size_t WS_Z1 = 293 * MiB;
constexpr size_t WS_APC = 303 * MiB;
constexpr size_t WS_APL = 320 * MiB;
constexpr size_t WS_END = 335 * MiB;
constexpr size_t APC_ML = (size_t)8192 * 4 * 2 * 64 * 4, APL_ML = (size_t)2048 * 4 * 7 * 64 * 4;

constexpr size_t O_Y = 0, O_CK = 10485760, O_CV = 12582912, O_SSD = 14680064, O_RET = 18874368;

constexpr int LDS_BYTES = 147456;

struct Args { const float* in[35]; float* out; unsigned char* ws; int ph_lo, ph_hi; };
typedef const __attribute__((address_space(4))) unsigned char* kargp_t;
__device__ __forceinline__ unsigned long long karg_u64(int off) { asm volatile("" : "+s"(off)); kargp_t kp = (kargp_t)__builtin_amdgcn_kernarg_segment_ptr(); return *(const __attribute__((address_space(4))) unsigned long long*)(kp + off); }
__device__ __forceinline__ int karg_i32(int off) { asm volatile("" : "+s"(off)); kargp_t kp = (kargp_t)__builtin_amdgcn_kernarg_segment_ptr(); return *(const __attribute__((address_space(4))) int*)(kp + off); }
#define INP(i) ((const float*)(const GAS float*)karg_u64(8 * (i)))
#define AOUT() ((float*)(GAS float*)karg_u64(8 * 35))
#define AWS() ((unsigned char*)(GAS unsigned char*)karg_u64(8 * 36))


#define LDS_WAIT() asm volatile("s_waitcnt lgkmcnt(0)" ::: "memory")
__device__ __forceinline__ float bf2f(unsigned short b) { return __uint_as_float(((unsigned)b) << 16); }
__device__ __forceinline__ unsigned f2bf(float f) { unsigned u = __float_as_uint(f); return (u + 0x7fffu + ((u >> 16) & 1u)) >> 16; }
__device__ __forceinline__ unsigned pk2(float lo, float hi) { return f2bf(lo) | (f2bf(hi) << 16); }
__device__ __forceinline__ float wave_sum(float v) {
#pragma unroll
    for (int o = 1; o < 64; o <<= 1) v += __shfl_xor(v, o);
    return v;
}
__device__ __forceinline__ float siluf(float v) { return v / (1.0f + __expf(-v)); }
__device__ __forceinline__ void seq_info(int sq, int& L, int& base) { if (sq < 32) { L = 256; base = sq * 256; } else { L = 1024; base = TCTX + (sq - 32) * 1024; } }

__device__ __forceinline__ void transpose_item(const float* __restrict__ W, int K, int Nsrc, bf16* WT, int k0, int n0, int drow0, LAS float* scr, int lane) {
    const int nn = n0 + (lane & 31); const bool ok = nn < Nsrc;
#pragma unroll 8
    for (int i = 0; i < 32; ++i) { const int kk = 2 * i + (lane >> 5); scr[kk * 33 + (lane & 31)] = ok ? W[(size_t)(k0 + kk) * Nsrc + nn] : 0.f; }
    LDS_WAIT();
    const int c = lane & 7;
#pragma unroll
    for (int j = 0; j < 4; ++j) { const int n = (lane >> 3) + 8 * j; const LAS float* s = scr + (8 * c) * 33 + n;
        u32x4 o; o.x = pk2(s[0 * 33], s[1 * 33]); o.y = pk2(s[2 * 33], s[3 * 33]); o.z = pk2(s[4 * 33], s[5 * 33]); o.w = pk2(s[6 * 33], s[7 * 33]);
        *(u32x4*)(WT + (size_t)(drow0 + n) * K + k0 + 8 * c) = o; }
    LDS_WAIT();
}

__device__ __forceinline__ void phase0(unsigned char* lds, int tid, int lane, int wave, int G) {
    const int bid = blockIdx.x;
    float* fl = (float*)lds;
    {
        const float* cc = INP(6); const float* cctx = INP(7); const float* wmod = INP(8); const float* bmod = INP(9);
        float* mod = (float*)(AWS() + WS_MOD);
        float* sc = fl;
        float* red = fl + 3072;
        for (int i = tid; i < 3072; i += NTHR) { const int ci = i >> 10, k = i & 1023; const float v = ci == 0 ? cctx[k] : cc[(ci - 1) * 1024 + k]; sc[i] = siluf(v); }
        __syncthreads();
        for (int it = bid; it < 288; it += G) {
            const int l = it / 144, col = (it % 144) * 64 + lane;
            const float* wp = wmod + ((size_t)l * 1024 + wave * 128) * 9216 + col;
            float a0 = 0.f, a1 = 0.f, a2 = 0.f;
#pragma unroll 8
            for (int k = 0; k < 128; ++k) { const float w = wp[(size_t)k * 9216]; const int kk = wave * 128 + k; a0 += sc[kk] * w; a1 += sc[1024 + kk] * w; a2 += sc[2048 + kk] * w; }
            red[(wave * 3 + 0) * 64 + lane] = a0; red[(wave * 3 + 1) * 64 + lane] = a1; red[(wave * 3 + 2) * 64 + lane] = a2;
            __syncthreads();
            if (tid < 192) { const int ci = tid >> 6, ln = tid & 63; float s = bmod[l * 9216 + (it % 144) * 64 + ln];
#pragma unroll
                for (int w = 0; w < 8; ++w) s += red[(w * 3 + ci) * 64 + ln];
                mod[((size_t)l * 3 + ci) * 9216 + (it % 144) * 64 + ln] = s; }
            __syncthreads();
        }
    }
    __syncthreads();
    {
        float* feats = fl;
        float* h1 = fl + 512;
        float* h2 = fl + 1024;
        const float MIN_DECAY = -3.0701134573253945f, MAX_DECAY = -15.350567286626973f;
        for (int it = bid; it < 320; it += G) {
            const int l = it / 160, r = it % 160; const int L = r < 32 ? 256 : 1024; const int pg = r < 32 ? r : r - 32;
            const float* w1 = INP(23) + l * 33 * 64; const float* b1 = INP(24) + l * 64; const float* w2 = INP(25) + l * 64 * 64; const float* b2 = INP(26) + l * 64;
            const float* w3 = INP(27) + (size_t)l * 64 * 1024; const float* fr = INP(28) + l * 64; const float* hb = INP(29) + l * 512;
            float* Hk = (float*)(AWS() + WS_HK + (size_t)l * HK_LAYER + (L == 256 ? 0 : HK1024_OFF));
            if (tid < 8 * 33) { const int pl = tid / 33, j = tid % 33; const float pos = (float)(pg * 8 + pl); float f;
                if (j == 0) f = pos / (float)(L - 1);
                else { const int b = (j - 1) & 15; const float band = 1e-4f + (float)b * ((15.0f - 1e-4f) / 15.0f); const float ang = (6.283185307179586f / (float)L) * pos * band; f = j <= 16 ? cosf(ang) : -sinf(ang); }
                feats[pl * 36 + j] = f; }
            __syncthreads();
            { const int pl = tid >> 6, j = tid & 63; float s = b1[j];
                for (int k = 0; k < 33; ++k) s += feats[pl * 36 + k] * w1[k * 64 + j];
                h1[pl * 64 + j] = sinf(fr[j] * s); }
            __syncthreads();
            { const int pl = tid >> 6, j = tid & 63; float s = b2[j];
                for (int k = 0; k < 64; ++k) s += h1[pl * 64 + k] * w2[k * 64 + j];
                h2[pl * 64 + j] = sinf(fr[j] * s); }
            __syncthreads();
#pragma unroll
            for (int cc = 0; cc < 2; ++cc) {
                const int col = tid + cc * 512;
                float acc[8];
#pragma unroll
                for (int p = 0; p < 8; ++p) acc[p] = 0.f;
                for (int k = 0; k < 64; ++k) { const float w = w3[k * 1024 + col];
#pragma unroll
                    for (int p = 0; p < 8; ++p) acc[p] += h2[p * 64 + k] * w; }
                const int c = col & 255, o = (col >> 8) & 1, dir = col >> 9;
                const float delta = fabsf(MIN_DECAY + (float)c * ((MAX_DECAY - MIN_DECAY) / 255.0f));
                float* Ho = Hk + (size_t)o * (2 * L - 1) * 256 + c;
#pragma unroll
                for (int p = 0; p < 8; ++p) { const int pos = pg * 8 + p; const float t = (float)pos / (float)(L - 1);
                    float v = acc[p] * __expf(-t * delta);
                    if (dir == 0) { if (pos == 0) v += hb[o * 256 + c]; Ho[(size_t)(L - 1 + pos) * 256] = v; }
                    else if (pos > 0) Ho[(size_t)(L - 1 - pos) * 256] = v; }
            }
            __syncthreads();
        }
    }
    __syncthreads();
    {
        LAS float* scr = (LAS float*)((LAS unsigned char*)lds + wave * 16384);
        const int gw = bid * NWAVES + wave, NGW = G * NWAVES;
        constexpr int I_IN = 16 * 176, I_OUT = 44 * 32, I_MI = 16 * 112, I_MO = 16 * 32, I_LAYER = 2 * I_IN + 2 * I_OUT + I_MI + I_MO;
        for (int it = gw; it < 2 * I_LAYER; it += NGW) {
            const int l = it / I_LAYER; int r = it % I_LAYER;
            unsigned char* wl = AWS() + WS_W + (size_t)l * W_LAYER;
            if (r < 2 * I_IN) { const int f = r / I_IN; r %= I_IN; const int kb = r / 176, nb = r % 176, n0 = nb * 32;
                const int isup = n0 >= DFF, ff = isup ? n0 - DFF : n0; const int drow0 = (ff >> 7) * 256 + isup * 128 + (ff & 127);
                transpose_item(INP(11) + (size_t)(l * 2 + f) * 1024 * 5632, 1024, 5632, (bf16*)(wl + (f ? W_IN1 : W_IN0)), kb * 64, n0, drow0, scr, lane); continue; }
            r -= 2 * I_IN;
            if (r < 2 * I_OUT) { const int f = r / I_OUT; r %= I_OUT; const int kb = r / 32, nb = r % 32;
                transpose_item(INP(12) + (size_t)(l * 2 + f) * 2816 * 1024, 2816, 1024, (bf16*)(wl + (f ? W_OUT1 : W_OUT0)), kb * 64, nb * 32, nb * 32, scr, lane); continue; }
            r -= 2 * I_OUT;
            if (r < I_MI) { const int kb = r / 112, nb = r % 112;
                transpose_item(INP(13) + (size_t)l * 1024 * DIN, 1024, DIN, (bf16*)(wl + W_MI), kb * 64, nb * 32, nb * 32, scr, lane); continue; }
            r -= I_MI;
            { const int kb = r / 32, nb = r % 32;
                transpose_item(INP(14) + (size_t)l * 1024 * 1024, 1024, 1024, (bf16*)(wl + W_MO), kb * 64, nb * 32, nb * 32, scr, lane); }
        }
    }
}

__device__ __forceinline__ void prep_phase(const float* xc, const float* xl, const float* nw, const float* modl, int p, bf16* H, int gw, int NGW, int lane) {
    f32x4 wv[4];
#pragma unroll
    for (int j = 0; j < 4; ++j) wv[j] = *(const f32x4*)(nw + 4 * lane + 256 * j);
    for (int row = gw; row < TT; row += NGW) {
        const float* x = (row < TCTX ? xc : xl) + (size_t)row * D;
        const int cidx = row < TCTX ? 0 : 1 + ((row - TCTX) >> 10);
        const float* sh = modl + (size_t)cidx * 9216 + (3 * p) * 1024; const float* sc = sh + 1024;
        f32x4 v[4]; float ss = 0.f;
#pragma unroll
        for (int j = 0; j < 4; ++j) { v[j] = *(const f32x4*)(x + 4 * lane + 256 * j); ss += (v[j].x * v[j].x + v[j].y * v[j].y) + (v[j].z * v[j].z + v[j].w * v[j].w); }
        const float rstd = rsqrtf(wave_sum(ss) * (1.0f / D) + EPS);
#pragma unroll
        for (int j = 0; j < 4; ++j) { const f32x4 s1 = *(const f32x4*)(sc + 4 * lane + 256 * j), s0 = *(const f32x4*)(sh + 4 * lane + 256 * j);
            const f32x4 y = (v[j] * rstd * wv[j]) * (s1 + 1.0f) + s0;
            u32x2 o; o.x = pk2(y.x, y.y); o.y = pk2(y.z, y.w);
            *(u32x2*)(H + (size_t)row * D + 4 * lane + 256 * j) = o; }
    }
}

__device__ __forceinline__ void m1_phase(int li, int gw, int NGW, int lane) {
    const bf16* U = (const bf16*)(AWS() + WS_UA);
    bf16* XBC = (bf16*)(AWS() + WS_XBC); float* QK = (float*)(AWS() + WS_QK);
    const float* cw = INP(15) + li * 3 * 768; const float* cb = INP(16) + li * 768;
    const float* qw = INP(32) + li * 64; const float* kw = INP(33) + li * 64;
    const float qwl = qw[lane], kwl = kw[lane];
    const int hf = lane >> 5, ri = lane & 31, fi = ri & 15;
    const float inv = exp2f(-(float)fi * (13.287712379549449f / 16.0f));
    for (int tok = gw; tok < TT; tok += NGW) {
        int sq, pos, L;
        if (tok < TCTX) { sq = tok >> 8; pos = tok & 255; L = 256; } else { sq = 32 + ((tok - TCTX) >> 10); pos = (tok - TCTX) & 1023; L = 1024; }
        const bf16* ur = U + (size_t)tok * DINP;
#pragma unroll
        for (int i = 0; i < 12; ++i) { const int ch = lane + 64 * i;
            const float c0 = bf2f(ur[U_XBC + ch]);
            const float cm = pos > 0 ? bf2f(ur[U_XBC + ch - DINP]) : 0.f;
            const float cp = pos < L - 1 ? bf2f(ur[U_XBC + ch + DINP]) : 0.f;
            const float v = cb[ch] + cw[ch] * cm + cw[768 + ch] * c0 + cw[1536 + ch] * cp;
            XBC[(size_t)tok * 768 + ch] = (bf16)f2bf(siluf(v)); }
        float sn = 0.f, cs = 1.f;
        if (sq >= 32) { const float pv = hf ? (float)(pos & 63) : (float)(pos >> 6); sincosf(pv * inv, &sn, &cs); }
#pragma unroll
        for (int h = 0; h < 6; ++h) {
            const float x = bf2f(ur[U_ATT + h * 64 + lane]);
            const float ss = wave_sum(x * x);
            float y = x * rsqrtf(ss * (1.0f / 64.0f) + EPS) * (h < 4 ? qwl : kwl);
            if (h >= 4 && sq < 32) AOUT()[O_CK + ((((size_t)sq * 2 + li) * 256 + pos) * 2 + (h - 4)) * 64 + lane] = y;
            if (sq >= 32) { const float yp = __shfl_xor(y, 16); y = (ri < 16) ? y * cs - yp * sn : yp * sn + y * cs; }
            QK[(size_t)tok * 384 + h * 64 + lane] = y;
        }
        if (sq < 32) {
#pragma unroll
            for (int kv = 0; kv < 2; ++kv) AOUT()[O_CV + ((((size_t)sq * 2 + li) * 256 + pos) * 2 + kv) * 64 + lane] = bf2f(ur[U_ATT + 384 + kv * 64 + lane]);
        }
    }
}

__device__ __forceinline__ void ssd_scalars(int li, int gw, int NGW, int lane) {
    const bf16* U = (const bf16*)(AWS() + WS_UA); float* SCG = (float*)(AWS() + WS_SCAL);
    for (int job = gw; job < 640; job += NGW) {
        const int cg = job >> 2, h = job & 3;
        const float dtb_f = INP(17)[(li * 2 + 0) * 4 + h], dtb_b = INP(17)[(li * 2 + 1) * 4 + h], an_f = -__expf(INP(18)[(li * 2 + 0) * 4 + h]), an_b = -__expf(INP(18)[(li * 2 + 1) * 4 + h]);
        const bf16* up = U + ((size_t)cg * 64 + lane) * DINP + U_DT + h;
        const float xf = bf2f(up[0]) + dtb_f, xb = bf2f(up[4]) + dtb_b;
        const float dtf = xf > 20.f ? xf : log1pf(__expf(xf)), dtbk = xb > 20.f ? xb : log1pf(__expf(xb));
        float cf = dtf * an_f, rc = dtbk * an_b;
#pragma unroll
        for (int o = 1; o < 64; o <<= 1) { const float t1 = __shfl_up(cf, o), t2 = __shfl_down(rc, o); if (lane >= o) cf += t1; if (lane + o < 64) rc += t2; }
        const float cfl = __shfl(cf, 63), rc0 = __shfl(rc, 0);
        float* o = SCG + (size_t)job * 576;
        o[lane] = cf; o[64 + lane] = rc; o[128 + lane] = dtf; o[192 + lane] = dtbk;
        o[256 + lane] = dtf * __expf(cfl - cf); o[320 + lane] = dtbk * __expf(rc0 - rc);
        o[384 + lane] = __expf(cf); o[448 + lane] = __expf(rc);
        if (lane == 0) { o[512] = __expf(cfl); o[513] = __expf(rc0); o[514] = 0.f; o[515] = 0.f; }
    }
}

typedef short sbf16x8 __attribute__((ext_vector_type(8)));
typedef float sf32x16 __attribute__((ext_vector_type(16)));
#define SC_MFMA(a, b, c) __builtin_amdgcn_mfma_f32_32x32x16_bf16((a), (b), (c), 0, 0, 0)
template <int N, bool SSD>
__device__ __forceinline__ void cscan_item(int li, int sq, int h, int pass, unsigned char* lds, int tid, int lane, int wave) {
    constexpr int RS = N + 8, TS = 72;
    constexpr int O_CQ = 0, O_BK = O_CQ + 64 * RS * 2, O_BKT = O_BK + 64 * RS * 2, O_VT = O_BKT + N * TS * 2, O_VWT = O_VT + 64 * TS * 2, O_ST = O_VWT + 64 * TS * 2,
                  O_YX = O_ST + 64 * RS * 2, O_SC = O_YX + 16384;
    static_assert(O_SC + 4096 <= 131072, "chunk scan LDS");
    constexpr int GR = 2 * (N / 8) + 8, R = (64 * GR) / NTHR;
    static_assert((64 * GR) % NTHR == 0, "chunk loader");
    int L, base; seq_info(sq, L, base);
    const int nch = L >> 6, g = h >> 1;
    const bf16* src = SSD ? (const bf16*)(AWS() + WS_XBC) : (const bf16*)(AWS() + WS_UA);
    const int sstr = SSD ? 768 : DINP;
    const int qoff = SSD ? 512 + g * 128 : U_RET + h * 64, koff = SSD ? 256 + g * 128 : U_RET + 256 + h * 64, voff = SSD ? h * 64 : U_RET + 512 + h * 64;
    float* Yout = (float*)(AWS() + (SSD ? WS_YS : WS_YR)) + (size_t)pass * TT * 256;
    const float* SCG = (const float*)(AWS() + WS_SCAL) + ((size_t)(base >> 6) * 4 + h) * 576;
    float* sc = (float*)(lds + O_SC);
    const int r = lane & 31, hh = lane >> 5;
    const bool has_state = SSD || wave < 4;
    const int nt = SSD ? (wave & 3) : (wave & 1), pt_s = SSD ? (wave >> 2) : ((wave >> 1) & 1);
    const int it = wave & 1, pt = (wave >> 1) & 1, kh = wave >> 2;
    uint4 pre[R]; f32x4 scv = (f32x4){0.f, 0.f, 0.f, 0.f}; float wj = 0.f;
    __syncthreads();
    if (!SSD) {
        const float d0 = INP(30)[(li * 2 + 0) * 4 + h], d1 = INP(30)[(li * 2 + 1) * 4 + h];
        const float lgf = -log1pf(__expf(-d0)), lgb = -log1pf(__expf(-d1));
        if (tid < 64) { const float cf = (float)(tid + 1) * lgf, rc = (float)(64 - tid) * lgb;
            sc[tid] = cf; sc[64 + tid] = rc; sc[128 + tid] = 0.125f; sc[192 + tid] = 0.125f;
            sc[256 + tid] = 0.125f * __expf((float)(63 - tid) * lgf); sc[320 + tid] = 0.125f * __expf((float)tid * lgb);
            sc[384 + tid] = __expf(cf); sc[448 + tid] = __expf(rc);
            if (tid == 0) { sc[512] = __expf(64.f * lgf); sc[513] = __expf(64.f * lgb); } }
        wj = 0.125f * (pass ? __expf((float)(tid & 63) * lgb) : __expf((float)(63 - (tid & 63)) * lgf));
    }
    sf32x16 accS;
    if (has_state) {
        if (sq < 32) {
#pragma unroll
            for (int i = 0; i < 16; ++i) accS[i] = 0.f;
        } else {
            const float* s0 = INP(SSD ? 4 : 5) + ((((size_t)(sq - 32) * 2 + li) * 2 + pass) * 4 + h) * (size_t)(N * 64);
#pragma unroll
            for (int i = 0; i < 16; ++i) accS[i] = s0[(32 * nt + (i & 3) + 8 * (i >> 2) + 4 * hh) * 64 + 32 * pt_s + r];
        }
    }
    auto issue = [&](int c) {
#pragma unroll
        for (int q = 0; q < R; ++q) { const int gi0 = tid + NTHR * q, j = gi0 & 63, gi = gi0 >> 6; const size_t tok = (size_t)base + c * 64 + j;
            const int col = gi < N / 8 ? qoff + 8 * gi : (gi < N / 4 ? koff + 8 * (gi - N / 8) : voff + 8 * (gi - N / 4));
            pre[q] = *(const uint4*)(src + tok * sstr + col); }
        if (SSD) { const float* scc = SCG + (size_t)c * (4 * 576); wj = scc[(pass ? 320 : 256) + (tid & 63)]; if (tid < 129) scv = *(const f32x4*)(scc + 4 * tid); }
    };
    issue(pass ? nch - 1 : 0);
    for (int cc = 0; cc < nch; ++cc) {
        const int c = pass ? nch - 1 - cc : cc;
        {
#pragma unroll
            for (int q = 0; q < R; ++q) { const int gi0 = tid + NTHR * q, j = gi0 & 63, gi = gi0 >> 6; const uint4 v = pre[q];
                if (gi < N / 8) { *(uint4*)(lds + O_CQ + (j * RS + 8 * gi) * 2) = v; }
                else if (gi < N / 4) { const int n0 = 8 * (gi - N / 8);
                    if (pass == 0) *(uint4*)(lds + O_BK + (j * RS + n0) * 2) = v;
                    bf16* bt = (bf16*)(lds + O_BKT) + n0 * TS + j; const unsigned w[4] = {v.x, v.y, v.z, v.w};
#pragma unroll
                    for (int e = 0; e < 4; ++e) { bt[(2 * e) * TS] = (bf16)(w[e] & 0xffffu); bt[(2 * e + 1) * TS] = (bf16)(w[e] >> 16); } }
                else { const int p0 = 8 * (gi - N / 4);
                    bf16* vt = (bf16*)(lds + O_VT) + p0 * TS + j; bf16* vw = (bf16*)(lds + O_VWT) + p0 * TS + j; const unsigned w[4] = {v.x, v.y, v.z, v.w};
#pragma unroll
                    for (int e = 0; e < 4; ++e) { const bf16 lo = (bf16)(w[e] & 0xffffu), hi = (bf16)(w[e] >> 16);
                        if (pass == 0) { vt[(2 * e) * TS] = lo; vt[(2 * e + 1) * TS] = hi; }
                        vw[(2 * e) * TS] = (bf16)f2bf(bf2f(lo) * wj); vw[(2 * e + 1) * TS] = (bf16)f2bf(bf2f(hi) * wj); } }
            }
            if (SSD && tid < 129) *(f32x4*)(sc + 4 * tid) = scv;
            if (has_state) { bf16* st = (bf16*)(lds + O_ST) + (32 * pt_s + r) * RS + 32 * nt + 4 * hh;
#pragma unroll
                for (int gq = 0; gq < 4; ++gq) { u32x2 o; o.x = pk2(accS[4 * gq], accS[4 * gq + 1]); o.y = pk2(accS[4 * gq + 2], accS[4 * gq + 3]); *(u32x2*)(st + 8 * gq) = o; } }
        }
        if (cc + 1 < nch) issue(pass ? c - 1 : c + 1);
        __syncthreads();
        sf32x16 accY, accQ;
#pragma unroll
        for (int i = 0; i < 16; ++i) { accY[i] = 0.f; accQ[i] = 0.f; }
        if (pass == 0) {
            sf32x16 gt;
#pragma unroll
            for (int i = 0; i < 16; ++i) gt[i] = 0.f;
            const unsigned char* ap = lds + O_BK + ((32 * kh + r) * RS + 8 * hh) * 2; const unsigned char* bp = lds + O_CQ + ((32 * it + r) * RS + 8 * hh) * 2;
#pragma unroll
            for (int s2 = 0; s2 < N / 16; ++s2) gt = SC_MFMA(*(const sbf16x8*)(ap + 32 * s2), *(const sbf16x8*)(bp + 32 * s2), gt);
            const float cfi = sc[32 * it + r], rci = sc[64 + 32 * it + r];
            float m[16];
#pragma unroll
            for (int e = 0; e < 16; ++e) { const int jl = (e & 3) + 8 * (e >> 2) + 4 * hh, j = 32 * kh + jl;
                float f = 0.f;
                if (kh < it || (kh == it && jl <= r)) f = sc[128 + j] * __expf(cfi - sc[j]);
                if (kh > it || (kh == it && jl >= r)) f += sc[192 + j] * __expf(rci - sc[64 + j]);
                m[e] = gt[e] * f; }
            const unsigned char* vp = lds + O_VT + ((32 * pt + r) * TS + 32 * kh + 4 * hh) * 2;
#pragma unroll
            for (int s2 = 0; s2 < 2; ++s2) {
                u32x4 av; av.x = pk2(m[8 * s2 + 0], m[8 * s2 + 1]); av.y = pk2(m[8 * s2 + 2], m[8 * s2 + 3]); av.z = pk2(m[8 * s2 + 4], m[8 * s2 + 5]); av.w = pk2(m[8 * s2 + 6], m[8 * s2 + 7]);
                const u32x2 b0 = *(const u32x2*)(vp + (16 * s2) * 2), b1 = *(const u32x2*)(vp + (16 * s2 + 8) * 2);
                u32x4 bv; bv.x = b0.x; bv.y = b0.y; bv.z = b1.x; bv.w = b1.y;
                accY = SC_MFMA(__builtin_bit_cast(sbf16x8, av), __builtin_bit_cast(sbf16x8, bv), accY);
            }
        }
        {
            const unsigned char* ap = lds + O_CQ + ((32 * it + r) * RS + (N / 2) * kh + 8 * hh) * 2; const unsigned char* bp = lds + O_ST + ((32 * pt + r) * RS + (N / 2) * kh + 8 * hh) * 2;
#pragma unroll
            for (int s2 = 0; s2 < N / 32; ++s2) accQ = SC_MFMA(*(const sbf16x8*)(ap + 32 * s2), *(const sbf16x8*)(bp + 32 * s2), accQ);
        }
        {
            const float* esc = sc + (pass ? 448 : 384) + 32 * it + 4 * hh;
#pragma unroll
            for (int e = 0; e < 16; ++e) accY[e] += esc[(e & 3) + 8 * (e >> 2)] * accQ[e];
        }
        float* yx = (float*)(lds + O_YX) + (it + 2 * pt) * 1024;
        if (kh == 1) {
#pragma unroll
            for (int e = 0; e < 16; ++e) yx[e * 64 + lane] = accY[e];
        }
        if (has_state) {
            const float dA = sc[512 + pass];
#pragma unroll
            for (int i = 0; i < 16; ++i) accS[i] *= dA;
            const unsigned char* ap = lds + O_BKT + ((32 * nt + r) * TS + 8 * hh) * 2; const unsigned char* bp = lds + O_VWT + ((32 * pt_s + r) * TS + 8 * hh) * 2;
#pragma unroll
            for (int s2 = 0; s2 < 4; ++s2) accS = SC_MFMA(*(const sbf16x8*)(ap + 32 * s2), *(const sbf16x8*)(bp + 32 * s2), accS);
        }
        __syncthreads();
        if (kh == 0) {
            float* yo = Yout + ((size_t)base + c * 64 + 32 * it + 4 * hh) * 256 + h * 64 + 32 * pt + r;
#pragma unroll
            for (int e = 0; e < 16; ++e) yo[(size_t)((e & 3) + 8 * (e >> 2)) * 256] = accY[e] + yx[e * 64 + lane];
        }
    }
    if (has_state && sq < 32) {
        float* so = AOUT() + (SSD ? O_SSD : O_RET) + ((((size_t)sq * 2 + li) * 2 + pass) * 4 + h) * (size_t)(N * 64);
#pragma unroll
        for (int i = 0; i < 16; ++i) so[(32 * nt + (i & 3) + 8 * (i >> 2) + 4 * hh) * 64 + 32 * pt_s + r] = accS[i];
    }
}

__device__ __forceinline__ void attn_item(int li, int sq, int kvh, int qb, int kt, unsigned char* lds, int tid, int lane, int wave) {
    int L, base; seq_info(sq, L, base);
    const bool lat = sq >= 32;
    const float* QK = (const float*)(AWS() + WS_QK); const bf16* U = (const bf16*)(AWS() + WS_UA);
    float* Ks = (float*)lds; float* Vs = Ks + 128 * 64;
    const int kb = qb + kt - 5;
    __syncthreads();
#pragma unroll
    for (int r = 0; r < 4; ++r) { const int e = tid + NTHR * r, j = e >> 4, c4 = (e & 15) * 4;
        f32x4 kq, vq;
        if (lat && kt < 4) { const size_t ci = ((((size_t)(sq - 32) * 2 + li) * 512 + kt * 128 + j) * 2 + kvh) * 64 + c4; kq = *(const f32x4*)(INP(2) + ci); vq = *(const f32x4*)(INP(3) + ci); }
        else { const size_t tok = (size_t)base + (lat ? kb : kt) * 128 + j; kq = *(const f32x4*)(QK + tok * 384 + 256 + kvh * 64 + c4);
            const u16x4 w = *(const u16x4*)(U + tok * DINP + U_ATT + 384 + kvh * 64 + c4); vq = (f32x4){bf2f(w.x), bf2f(w.y), bf2f(w.z), bf2f(w.w)}; }
        *(f32x4*)(Ks + j * 64 + c4) = kq; *(f32x4*)(Vs + j * 64 + c4) = vq; }
    const int pair = tid & 255, khalf = tid >> 8, qi = pair & 127, hh = pair >> 7, head = kvh * 2 + hh;
    const size_t qtok = (size_t)base + qb * 128 + qi;
    f32x4 q[16], o[16];
#pragma unroll
    for (int i = 0; i < 16; ++i) { q[i] = *(const f32x4*)(QK + qtok * 384 + head * 64 + 4 * i) * 0.125f; o[i] = (f32x4){0.f, 0.f, 0.f, 0.f}; }
    float m = -1e30f, l = 0.f;
    __syncthreads();
    const bool masked = lat && kt >= 4;
    const int qpos = qb * 128 + qi;
    for (int jj = 0; jj < 64; ++jj) {
        const int j = khalf * 64 + jj;
        f32x4 sa = (f32x4){0.f, 0.f, 0.f, 0.f};
#pragma unroll
        for (int i = 0; i < 16; ++i) sa += q[i] * *(const f32x4*)(Ks + j * 64 + 4 * i);
        const float s = (sa.x + sa.y) + (sa.z + sa.w);
        bool valid = true;
        if (masked) { const int d = qpos - (kb * 128 + j); valid = (d <= 128) && (d >= -128); }
        if (valid) {
            if (s > m) { const float corr = __expf(m - s); l *= corr;
#pragma unroll
                for (int i = 0; i < 16; ++i) o[i] *= corr;
                m = s; }
            const float pexp = __expf(s - m); l += pexp;
#pragma unroll
            for (int i = 0; i < 16; ++i) o[i] += pexp * *(const f32x4*)(Vs + j * 64 + 4 * i);
        }
    }
    __syncthreads();
    float* mg = (float*)lds + pair * 68;
    if (khalf == 1) { mg[0] = m; mg[1] = l;
#pragma unroll
        for (int i = 0; i < 16; ++i) *(f32x4*)(mg + 4 + 4 * i) = o[i]; }
    __syncthreads();
    if (khalf == 0) { const float m1 = mg[0], l1 = mg[1]; const float M = fmaxf(m, m1), c0 = __expf(m - M), c1 = __expf(m1 - M);
        mg[0] = M; mg[1] = l * c0 + l1 * c1;
#pragma unroll
        for (int i = 0; i < 16; ++i) { const f32x4 o1 = *(const f32x4*)(mg + 4 + 4 * i); *(f32x4*)(mg + 4 + 4 * i) = o[i] * c0 + o1 * c1; } }
    __syncthreads();
    float* OP = (float*)(AWS() + (lat ? WS_APL : WS_APC)); float* MLp = (float*)(AWS() + (lat ? WS_APL + APL_ML : WS_APC + APC_ML));
    const int NS = lat ? 7 : 2; const size_t tb = lat ? (size_t)(base - TCTX) : (size_t)base;
    for (int pr = wave * 32; pr < wave * 32 + 32; ++pr) { const int qq = pr & 127, hd = kvh * 2 + (pr >> 7);
        const size_t idx = ((tb + qb * 128 + qq) * 4 + hd) * NS + kt; const float* src = (const float*)lds + pr * 68;
        OP[idx * 64 + lane] = src[4 + lane];
        if (lane < 2) MLp[idx * 2 + lane] = src[lane]; }
}


__device__ __forceinline__ void attn_mfma_item(int li, int sq, int kvh, int qb, int kt, unsigned char* lds, int tid, int lane, int wave) {
    constexpr int KSTR = 72, VSTR = 136, O_KS = 0, O_VTS = 128 * KSTR * 2;
    int L, base; seq_info(sq, L, base);
    const bool lat = sq >= 32;
    const float* QK = (const float*)(AWS() + WS_QK); const bf16* U = (const bf16*)(AWS() + WS_UA);
    const int kb = qb + kt - 5;
    __syncthreads();
#pragma unroll
    for (int q = 0; q < 4; ++q) { const int gI = tid + NTHR * q, key = gI & 127, d4 = (gI >> 7) * 4;
        f32x4 kq, vq;
        if (lat && kt < 4) { const size_t ci = ((((size_t)(sq - 32) * 2 + li) * 512 + kt * 128 + key) * 2 + kvh) * 64 + d4; kq = *(const f32x4*)(INP(2) + ci); vq = *(const f32x4*)(INP(3) + ci); }
        else { const size_t tok = (size_t)base + (lat ? kb : kt) * 128 + key; kq = *(const f32x4*)(QK + tok * 384 + 256 + kvh * 64 + d4);
            const u16x4 w = *(const u16x4*)(U + tok * DINP + U_ATT + 384 + kvh * 64 + d4); vq = (f32x4){bf2f(w.x), bf2f(w.y), bf2f(w.z), bf2f(w.w)}; }
        u32x2 kw; kw.x = pk2(kq.x, kq.y); kw.y = pk2(kq.z, kq.w);
        *(u32x2*)(lds + O_KS + (key * KSTR + d4) * 2) = kw;
        bf16* vt = (bf16*)(lds + O_VTS) + d4 * VSTR + key;
        vt[0] = (bf16)f2bf(vq.x); vt[VSTR] = (bf16)f2bf(vq.y); vt[2 * VSTR] = (bf16)f2bf(vq.z); vt[3 * VSTR] = (bf16)f2bf(vq.w); }
    const int r = lane & 31, hh = lane >> 5, head = kvh * 2 + (wave >> 2), q0 = 32 * (wave & 3);
    const size_t qtok = (size_t)base + qb * 128 + q0 + r;
    sbf16x8 qf[4];
#pragma unroll
    for (int s2 = 0; s2 < 4; ++s2) { const float* qp = QK + qtok * 384 + head * 64 + 16 * s2 + 8 * hh; const f32x4 a0 = *(const f32x4*)qp * 0.125f, a1 = *(const f32x4*)(qp + 4) * 0.125f;
        u32x4 w; w.x = pk2(a0.x, a0.y); w.y = pk2(a0.z, a0.w); w.z = pk2(a1.x, a1.y); w.w = pk2(a1.z, a1.w); qf[s2] = __builtin_bit_cast(sbf16x8, w); }
    __syncthreads();
    sf32x16 st[4];
#pragma unroll
    for (int t4 = 0; t4 < 4; ++t4) {
#pragma unroll
        for (int i = 0; i < 16; ++i) st[t4][i] = 0.f;
        const unsigned char* ap = lds + O_KS + ((32 * t4 + r) * KSTR + 8 * hh) * 2;
#pragma unroll
        for (int s2 = 0; s2 < 4; ++s2) st[t4] = SC_MFMA(*(const sbf16x8*)(ap + 32 * s2), qf[s2], st[t4]);
    }
    const bool masked = lat && kt >= 4;
    const int qpos = qb * 128 + q0 + r;
    float m = -1e30f;
#pragma unroll
    for (int t4 = 0; t4 < 4; ++t4)
#pragma unroll
        for (int e = 0; e < 16; ++e) { if (masked) { const int d = qpos - (kb * 128 + 32 * t4 + (e & 3) + 8 * (e >> 2) + 4 * hh); if (d > 128 || d < -128) st[t4][e] = -1e30f; }
            m = fmaxf(m, st[t4][e]); }
    m = fmaxf(m, __shfl_xor(m, 32));
    float l = 0.f;
#pragma unroll
    for (int t4 = 0; t4 < 4; ++t4)
#pragma unroll
        for (int e = 0; e < 16; ++e) { const float p = __expf(st[t4][e] - m); st[t4][e] = p; l += p; }
    l += __shfl_xor(l, 32);
    sf32x16 o0, o1;
#pragma unroll
    for (int i = 0; i < 16; ++i) { o0[i] = 0.f; o1[i] = 0.f; }
#pragma unroll
    for (int t4 = 0; t4 < 4; ++t4)
#pragma unroll
        for (int s2 = 0; s2 < 2; ++s2) {
            u32x4 av; av.x = pk2(st[t4][8 * s2 + 0], st[t4][8 * s2 + 1]); av.y = pk2(st[t4][8 * s2 + 2], st[t4][8 * s2 + 3]); av.z = pk2(st[t4][8 * s2 + 4], st[t4][8 * s2 + 5]); av.w = pk2(st[t4][8 * s2 + 6], st[t4][8 * s2 + 7]);
            const sbf16x8 a8 = __builtin_bit_cast(sbf16x8, av);
            const unsigned char* vp = lds + O_VTS + (r * VSTR + 32 * t4 + 16 * s2 + 4 * hh) * 2;
            { const u32x2 b0 = *(const u32x2*)vp, b1 = *(const u32x2*)(vp + 16); u32x4 bv; bv.x = b0.x; bv.y = b0.y; bv.z = b1.x; bv.w = b1.y; o0 = SC_MFMA(a8, __builtin_bit_cast(sbf16x8, bv), o0); }
            { const u32x2 b0 = *(const u32x2*)(vp + 32 * VSTR * 2), b1 = *(const u32x2*)(vp + 32 * VSTR * 2 + 16); u32x4 bv; bv.x = b0.x; bv.y = b0.y; bv.z = b1.x; bv.w = b1.y; o1 = SC_MFMA(a8, __builtin_bit_cast(sbf16x8, bv), o1); }
        }
    float* OP = (float*)(AWS() + (lat ? WS_APL : WS_APC)); float* MLp = (float*)(AWS() + (lat ? WS_APL + APL_ML : WS_APC + APC_ML));
    const int NS = lat ? 7 : 2; const size_t tb = lat ? (size_t)(base - TCTX) : (size_t)base;
#pragma unroll
    for (int e = 0; e < 16; ++e) { const int qr = (e & 3) + 8 * (e >> 2) + 4 * hh; const size_t idx = ((tb + qb * 128 + q0 + qr) * 4 + head) * NS + kt;
        OP[idx * 64 + r] = o0[e]; OP[idx * 64 + 32 + r] = o1[e]; }
    if (hh == 0) { const size_t idx = ((tb + qb * 128 + q0 + r) * 4 + head) * NS + kt; *(f32x2*)(MLp + idx * 2) = (f32x2){m, l}; }
}

typedef short hbf16x8 __attribute__((ext_vector_type(8)));
typedef float f32x16 __attribute__((ext_vector_type(16)));
constexpr int HY_FIL = 0, HY_Z = 32768, HY_XG = 49152, HY_ZERO = 65536;
template <int ORDER>
__device__ __forceinline__ void hyena_mfma_item(int li, int lat, int cq, int sgp, unsigned char* lds, int tid, int lane, int wave) {
    const int L = lat ? 1024 : 256, T = L >> 5, c0 = cq * 4;
    const float* Hk = (const float*)(AWS() + WS_HK + (size_t)li * HK_LAYER + (lat ? HK1024_OFF : 0)) + (size_t)ORDER * (2 * L - 1) * 256 + c0;
    const bf16* U = (const bf16*)(AWS() + WS_UA); bf16* Z1T = (bf16*)(AWS() + WS_Z1);
    const float* cw = INP(21) + li * 3 * 768; const float* cb = INP(22) + li * 768;
    bf16* FIL = (bf16*)(lds + HY_FIL); bf16* Zs = (bf16*)(lds + HY_Z); bf16* XG = (bf16*)(lds + HY_XG);
    __syncthreads();
    for (int lam = tid; lam < 2 * L - 1; lam += NTHR) {
        const f32x4 f = *(const f32x4*)(Hk + (size_t)lam * 256); const int x = 2 * L - 2 - lam;
#pragma unroll
        for (int ch = 0; ch < 4; ++ch) { const bf16 v = (bf16)f2bf(f[ch]); FIL[(ch * 2 + 0) * 2048 + x] = v; if (x >= 1) FIL[(ch * 2 + 1) * 2048 + x - 1] = v; }
    }
    if (tid < 8) ((unsigned*)(lds + HY_ZERO))[tid] = 0u;
    const int cz = c0, cg = 256 * (ORDER + 1) + c0;
    float wz[3][4], bz[4], wg[3][4], bg[4];
#pragma unroll
    for (int ch = 0; ch < 4; ++ch) { bz[ch] = cb[cz + ch]; bg[ch] = cb[cg + ch];
#pragma unroll
        for (int i = 0; i < 3; ++i) { wz[i][ch] = cw[i * 768 + cz + ch]; wg[i][ch] = cw[i * 768 + cg + ch]; } }
#pragma unroll
    for (int q = 0; q < 4; ++q) {
        const int p = tid + NTHR * q, sg2 = p >> 10, t = p & 1023, pos = t & (L - 1);
        const size_t tok = (size_t)(lat ? TCTX : 0) + (size_t)(sgp * 2 + sg2) * 1024 + t;
        const bf16* ur = U + tok * DINP + U_HY;
        const bool hasl = pos > 0, hasr = pos < L - 1;
        const u16x4 g0 = *(const u16x4*)(ur + cg), gl = hasl ? *(const u16x4*)(ur + cg - DINP) : (u16x4){0, 0, 0, 0}, gr = hasr ? *(const u16x4*)(ur + cg + DINP) : (u16x4){0, 0, 0, 0};
        u16x4 z0 = (u16x4){0, 0, 0, 0}, zl = z0, zr = z0;
        if (ORDER == 0) { z0 = *(const u16x4*)(ur + cz); if (hasl) zl = *(const u16x4*)(ur + cz - DINP); if (hasr) zr = *(const u16x4*)(ur + cz + DINP); }
#pragma unroll
        for (int ch = 0; ch < 4; ++ch) {
            const float gv = bg[ch] + wg[0][ch] * bf2f(gl[ch]) + wg[1][ch] * bf2f(g0[ch]) + wg[2][ch] * bf2f(gr[ch]);
            XG[(ch * 2 + sg2) * 1024 + t] = (bf16)f2bf(gv);
            bf16 zv;
            if (ORDER == 0) zv = (bf16)f2bf(bz[ch] + wz[0][ch] * bf2f(zl[ch]) + wz[1][ch] * bf2f(z0[ch]) + wz[2][ch] * bf2f(zr[ch]));
            else zv = Z1T[(size_t)(c0 + ch) * TT + tok];
            Zs[(ch * 2 + sg2) * 1024 + t] = zv;
        }
    }
    __syncthreads();
    const int chl = wave & 3, sg2 = wave >> 2;
    const int a = lane & 31, hh = lane >> 5, icol = lat ? a : (a & 7);
    const int par = (L - 1 - a) & 1;
    const LAS unsigned char* filb = (const LAS unsigned char*)lds + HY_FIL + (chl * 2 + par) * 4096 + 2 * ((L - 1) - a + 8 * hh - par);
    const LAS unsigned char* zb = (const LAS unsigned char*)lds + HY_Z + (chl * 2 + sg2) * 2048 + 2 * (32 * a + 8 * hh);
    const LAS unsigned char* zero = (const LAS unsigned char*)lds + HY_ZERO;
    f32x16 acc;
#pragma unroll
    for (int i = 0; i < 16; ++i) acc[i] = 0.f;
    for (int d = -(T - 1); d <= T - 1; ++d) {
        const int j = icol - d; const bool ok = (j >= 0) && (j < T);
#pragma unroll
        for (int kap = 0; kap < 2; ++kap) {
            const LAS unsigned* fp = (const LAS unsigned*)(filb + 2 * (16 * kap - 32 * d));
            u32x4 av; av.x = fp[0]; av.y = fp[1]; av.z = fp[2]; av.w = fp[3];
            const u32x4 bv = *(const LAS u32x4*)(ok ? zb + 2 * (16 * kap - 32 * d) : zero);
            acc = __builtin_amdgcn_mfma_f32_32x32x16_bf16(__builtin_bit_cast(hbf16x8, av), __builtin_bit_cast(hbf16x8, bv), acc, 0, 0, 0);
        }
    }
    const size_t tb = (size_t)(lat ? TCTX : 0) + (size_t)(sgp * 2 + sg2) * 1024;
    const bf16* xg = XG + (chl * 2 + sg2) * 1024 + 32 * a + 4 * hh;
#pragma unroll
    for (int g = 0; g < 4; ++g) {
        const u16x4 gq = *(const u16x4*)(xg + 8 * g);
        const float y0 = acc[4 * g + 0] * bf2f(gq.x), y1 = acc[4 * g + 1] * bf2f(gq.y), y2 = acc[4 * g + 2] * bf2f(gq.z), y3 = acc[4 * g + 3] * bf2f(gq.w);
        const size_t t = tb + 32 * a + 8 * g + 4 * hh;
        if (ORDER == 0) { u32x2 o; o.x = pk2(y0, y1); o.y = pk2(y2, y3); *(u32x2*)(Z1T + (size_t)(c0 + chl) * TT + t) = o; }
        else { bf16* ym = (bf16*)(AWS() + WS_YMIX) + t * D + 256 + c0 + chl; ym[0] = (bf16)f2bf(y0); ym[D] = (bf16)f2bf(y1); ym[2 * D] = (bf16)f2bf(y2); ym[3 * D] = (bf16)f2bf(y3); }
    }
}

__device__ __forceinline__ void finalize_token(int li, int tok, int lane) {
    const bf16* ur = (const bf16*)(AWS() + WS_UA) + (size_t)tok * DINP;
    bf16* ym = (bf16*)(AWS() + WS_YMIX) + (size_t)tok * D;
    const float* YS = (const float*)(AWS() + WS_YS); const float* YR = (const float*)(AWS() + WS_YR); const bf16* XBC = (const bf16*)(AWS() + WS_XBC);
    const int ch0 = lane * 4, hd = lane >> 4;
    {
        const f32x4 yf = *(const f32x4*)(YS + (size_t)tok * 256 + ch0), yb = *(const f32x4*)(YS + ((size_t)TT + tok) * 256 + ch0);
        const u16x4 xw = *(const u16x4*)(XBC + (size_t)tok * 768 + ch0); const f32x4 xs = (f32x4){bf2f(xw.x), bf2f(xw.y), bf2f(xw.z), bf2f(xw.w)};
        const u16x4 zw = *(const u16x4*)(ur + U_Z + ch0);
        const float dsk = INP(19)[li * 4 + hd];
        f32x4 y = yf + yb + xs * dsk;
        y.x *= siluf(bf2f(zw.x)); y.y *= siluf(bf2f(zw.y)); y.z *= siluf(bf2f(zw.z)); y.w *= siluf(bf2f(zw.w));
        const float ss = wave_sum((y.x * y.x + y.y * y.y) + (y.z * y.z + y.w * y.w));
        const float rstd = rsqrtf(ss * (1.0f / 256.0f) + EPS);
        const f32x4 nw = *(const f32x4*)(INP(20) + li * 256 + ch0);
        y = y * rstd * nw;
        u32x2 o; o.x = pk2(y.x, y.y); o.y = pk2(y.z, y.w); *(u32x2*)(ym + ch0) = o;
    }
    {
        const f32x4 yf = *(const f32x4*)(YR + (size_t)tok * 256 + ch0), yb = *(const f32x4*)(YR + ((size_t)TT + tok) * 256 + ch0);
        f32x4 y = yf + yb;
        float s = (y.x + y.y) + (y.z + y.w);
        s += __shfl_xor(s, 1); s += __shfl_xor(s, 2); s += __shfl_xor(s, 4); s += __shfl_xor(s, 8);
        const float mu = s * (1.0f / 64.0f);
        y = y - mu;
        float q = (y.x * y.x + y.y * y.y) + (y.z * y.z + y.w * y.w);
        q += __shfl_xor(q, 1); q += __shfl_xor(q, 2); q += __shfl_xor(q, 4); q += __shfl_xor(q, 8);
        const float rstd = rsqrtf(q * (1.0f / 64.0f) + EPS);
        const f32x4 gw = *(const f32x4*)(INP(31) + li * 256 + ch0);
        const u16x4 gg = *(const u16x4*)(ur + U_RET + 768 + ch0);
        y = y * rstd * gw;
        y.x *= siluf(bf2f(gg.x)); y.y *= siluf(bf2f(gg.y)); y.z *= siluf(bf2f(gg.z)); y.w *= siluf(bf2f(gg.w));
        u32x2 o; o.x = pk2(y.x, y.y); o.y = pk2(y.z, y.w); *(u32x2*)(ym + 512 + ch0) = o;
    }
    {
        const bool lat = tok >= TCTX;
        const float* OP = (const float*)(AWS() + (lat ? WS_APL : WS_APC)); const float* MLp = (const float*)(AWS() + (lat ? WS_APL + APL_ML : WS_APC + APC_ML));
        const int NS = lat ? 7 : 2; const size_t tb = lat ? (size_t)(tok - TCTX) : (size_t)tok;
        const int qb = lat ? (((tok - TCTX) & 1023) >> 7) : 0;
#pragma unroll
        for (int h = 0; h < 4; ++h) {
            const size_t idx = (tb * 4 + h) * NS;
            float ms = -1e30f, ls = 0.f;
            const bool sv = lane < NS && !(lat && ((lane == 4 && qb == 0) || (lane == 6 && qb == 7)));
            if (sv) { const f32x2 t = *(const f32x2*)(MLp + (idx + lane) * 2); ms = t.x; ls = t.y; }
            const float sink = INP(34)[li * 4 + h];
            float M = ms;
#pragma unroll
            for (int o = 1; o < 8; o <<= 1) M = fmaxf(M, __shfl_xor(M, o));
            M = fmaxf(M, sink);
            const float w = sv ? __expf(ms - M) : 0.f;
            float den = w * ls;
#pragma unroll
            for (int o = 1; o < 8; o <<= 1) den += __shfl_xor(den, o);
            den += __expf(sink - M);
            den = __shfl(den, 0);
            float ov = 0.f;
            for (int s = 0; s < NS; ++s) { const float ws_ = __shfl(w, s); if (ws_ != 0.f) ov += ws_ * OP[(idx + s) * 64 + lane]; }
            ym[768 + h * 64 + lane] = (bf16)f2bf(ov / den);
        }
    }
}


#define XB_TMO      128
#define XB_XCNT(j)  (256  + 64 * (j))
#define XB_XSUB(j)  (1280 + 64 * (j))
#define XB_XGEN(j)  (2304 + 64 * (j))
#define XB_TOP      3328
#define XB_TOPGEN   3392
#define XCD_BAR_WORDS 3456
#define XB_SPIN_CAP (1u << 18)
__device__ __forceinline__ unsigned xb_ld(unsigned* p)              { return __hip_atomic_load(p, __ATOMIC_RELAXED, __HIP_MEMORY_SCOPE_AGENT); }
__device__ __forceinline__ unsigned xb_add(unsigned* p, unsigned v) { return __hip_atomic_fetch_add(p, v, __ATOMIC_RELAXED, __HIP_MEMORY_SCOPE_AGENT); }
__device__ __forceinline__ unsigned xb_xcc_id() { return (unsigned)__builtin_amdgcn_s_getreg((3 << 11) | 20) & 0xFu; }
#define XB_SPIN(cond, bar) do { unsigned _sp = 0; while (cond) { __builtin_amdgcn_s_sleep(1); \
    if ((++_sp & 255u) == 0u) { if (xb_ld(&(bar)[XB_TMO])) break; if (_sp > XB_SPIN_CAP) { atomicAdd(&(bar)[XB_TMO], 1u); break; } } } } while (0)
__device__ __forceinline__ void xcd_barrier_complete(unsigned* bar, unsigned x, unsigned& nloc, unsigned& nx) {
    const unsigned G = gridDim.x * gridDim.y * gridDim.z;
    unsigned sum, cnt, mine, sp = 0u;
    for (;;) {
        sum = 0u; cnt = 0u; mine = 0u;
#pragma unroll
        for (unsigned j = 0; j < 16; ++j) { const unsigned c = xb_ld(&bar[XB_XCNT(j)]); sum += c; cnt += (c > 0u) ? 1u : 0u; mine = (j == x) ? c : mine; }
        if (sum == G) break;
        __builtin_amdgcn_s_sleep(1);
        if ((++sp & 255u) == 0u) { if (xb_ld(&bar[XB_TMO])) break; if (sp > XB_SPIN_CAP) { atomicAdd(&bar[XB_TMO], 1u); break; } }
    }
    nloc = mine > 0u ? mine : 1u; nx = cnt > 0u ? cnt : 1u;
}
__device__ __forceinline__ void xcd_barrier(unsigned* bar, volatile LAS unsigned* st) {
    asm volatile("s_waitcnt vmcnt(0)" ::: "memory");
    __syncthreads();
    if (threadIdx.x == 0) {
        const unsigned x = xb_xcc_id();
        __builtin_amdgcn_s_waitcnt(0);
        unsigned nloc = st[0], nx = st[1];
        if (nloc == 0u) { xcd_barrier_complete(bar, x, nloc, nx); st[0] = nloc; st[1] = nx; }
        const unsigned old = xb_add(&bar[XB_XSUB(x)], 1u);
        const unsigned gen = old / nloc;
        if (old + 1u == (gen + 1u) * nloc) {
            __builtin_amdgcn_fence(__ATOMIC_RELEASE, "agent");
            asm volatile("s_waitcnt vmcnt(0)" ::: "memory");
            const unsigned og = xb_add(&bar[XB_TOP], 1u);
            const unsigned tg = og / nx;
            if (og + 1u == (tg + 1u) * nx) xb_add(&bar[XB_TOPGEN], 1u);
            else XB_SPIN(xb_ld(&bar[XB_TOPGEN]) == tg, bar);
            __builtin_amdgcn_fence(__ATOMIC_ACQUIRE, "agent");
            xb_add(&bar[XB_XGEN(x)], 1u);
            asm volatile("s_waitcnt vmcnt(0)" ::: "memory");
        } else {
            XB_SPIN(xb_ld(&bar[XB_XGEN(x)]) == gen, bar);
            __builtin_amdgcn_fence(__ATOMIC_ACQUIRE, "agent");
            asm volatile("s_waitcnt vmcnt(0)" ::: "memory");
        }
    }
    __syncthreads();
}

__device__ __forceinline__ int dq_next(unsigned* ctr, volatile int* slot, int tid) {
    __syncthreads();
    if (tid == 0) *slot = (int)__hip_atomic_fetch_add(ctr, 1u, __ATOMIC_RELAXED, __HIP_MEMORY_SCOPE_AGENT);
    __syncthreads();
    return *slot;
}

__global__ void __launch_bounds__(NTHR, 2) mk_fwd(Args a) {
    extern __shared__ __attribute__((aligned(16))) unsigned char lds[];
    const int ph_hi = karg_i32(8 * 37 + 4);
    if (threadIdx.x < 64) ((volatile LAS unsigned*)((LAS unsigned char*)lds + 131072))[threadIdx.x] = 0u;
    __syncthreads();
    if (!MK_MULTI && threadIdx.x == 0) (void)xb_add((unsigned*)(AWS() + WS_CTL) + CW_BAR + XB_XCNT(xb_xcc_id()), 1u);
    for (int ph = karg_i32(8 * 37); ph < ph_hi; ++ph) {
        int nrep = 1;
        if (MK_REP) { const int k = (ph - 1) % 12;
            if (ph == 0) nrep += REP(0);
            else if (ph < NPHASE) nrep += (k == 0 || k == 3 || k == 9) ? REP(1) : (k == 1 || k == 10) ? REP(2) : (k == 2 || k == 8 || k == 11) ? REP(3) : k == 4 ? REP(4) : k == 5 ? REP(5) : k == 6 ? REP(6) : REP(7); }
        for (int rep = 0; rep < nrep; ++rep) {
        int tid = threadIdx.x; asm volatile("" : "+v"(tid));
        int G = gridDim.x, bid = blockIdx.x; asm volatile("" : "+s"(G), "+s"(bid));
        const int lane = tid & 63, wave = __builtin_amdgcn_readfirstlane(tid >> 6);
        const int gw = bid * NWAVES + wave, NGW = G * NWAVES;
        unsigned* ctl = (unsigned*)(AWS() + WS_CTL);
        volatile int* qslot = (volatile int*)(lds + 131072 + 64);
        float* xbuf = AOUT() + O_Y;
        if (rep) xcd_barrier((unsigned*)(AWS() + WS_CTL) + CW_BAR, (volatile LAS unsigned*)((LAS unsigned char*)lds + 131072 + 128));
        if (ph == 0) {
            if (EN(0)) phase0(lds, tid, lane, wave, G);
        } else if (ph == NPHASE) {
            float* o = AOUT();
#define ZERO_OUT(i, lo, hi) if (!((MK_KEEP >> (i)) & 1)) for (size_t e = (size_t)(lo) + (size_t)bid * NTHR + tid; e < (size_t)(hi); e += (size_t)G * NTHR) o[e] = 0.f;
            ZERO_OUT(0, 0, 8388608) ZERO_OUT(1, 8388608, 10485760) ZERO_OUT(2, 10485760, 12582912) ZERO_OUT(3, 12582912, 14680064) ZERO_OUT(4, 14680064, 18874368) ZERO_OUT(5, 18874368, 20971520)
        } else {
            const int li = (ph - 1) / 12, k = (ph - 1) % 12;
            const float* modl = (const float*)(AWS() + WS_MOD) + (size_t)li * 3 * 9216;
            unsigned char* wl = AWS() + WS_W + (size_t)li * W_LAYER;
            const bool first = (li == 0 && k <= 2);
            const float* xc = first ? INP(0) : xbuf;
            const float* xl = first ? INP(1) - (size_t)TCTX * D : xbuf;
            if (k == 0 || k == 3 || k == 9) {
                const int p = k == 0 ? 0 : (k == 3 ? 1 : 2);
                if (EN(1)) prep_phase(xc, xl, INP(10) + (li * 3 + p) * 1024, modl, p, (bf16*)(AWS() + WS_H), gw, NGW, lane);
            } else if (k == 1 || k == 10) {
                pg8::Gemm g{(const bf16*)(AWS() + WS_H), (const bf16*)(wl + (k == 1 ? W_IN0 : W_IN1)), TT, 2 * DFF, D};
                pg8::StaticOrder S; S.init(TT, 2 * DFF, G, bid);
                pg8::EpiSwiglu E{(bf16*)(AWS() + WS_UA), DFF};
                if (EN(2)) pg8::gemm_phase<pg8::EpiSwiglu, pg8::StaticOrder, true, true>((LAS unsigned char*)lds, g, S, E, tid);
            } else if (k == 2 || k == 8 || k == 11) {
                const bool mix = (k == 8);
                pg8::Gemm g{(const bf16*)(AWS() + (mix ? WS_YMIX : WS_UA)), (const bf16*)(wl + (mix ? W_MO : (k == 2 ? W_OUT0 : W_OUT1))), TT, D, mix ? D : DFF};
                pg8::StaticOrder S; S.init(TT, D, G, bid);
                const int gi = k == 2 ? 2 : (k == 8 ? 5 : 8);
                pg8::EpiResid E{xc, xl, (rep + 1 < nrep) ? (float*)(AWS() + WS_XBC) : xbuf, modl + gi * 1024, mix ? 1.0f : 0.5f};
                if (EN(3)) pg8::gemm_phase<pg8::EpiResid, pg8::StaticOrder, true, true>((LAS unsigned char*)lds, g, S, E, tid);
            } else if (k == 4) {
                pg8::Gemm g{(const bf16*)(AWS() + WS_H), (const bf16*)(wl + W_MI), TT, DINP, D};
                pg8::StaticOrder S; S.init(TT, DINP, G, bid);
                pg8::EpiBf16 E{(bf16*)(AWS() + WS_UA), DINP};
                if (EN(4)) pg8::gemm_phase<pg8::EpiBf16, pg8::StaticOrder, true, true>((LAS unsigned char*)lds, g, S, E, tid);
            } else if (k == 5) {
                if (EN(5)) { m1_phase(li, gw, NGW, lane); ssd_scalars(li, gw, NGW, lane); }
            } else if (k == 6) {
                for (;;) {
                    int it = dq_next(ctl + ph + 32 * rep, qslot, threadIdx.x);
                    if (it >= 1344) break;
                    int tid = threadIdx.x, li = (ph - 1) / 12; asm volatile("" : "+v"(tid)); asm volatile("" : "+s"(li));
                    const int lane = tid & 63, wave = __builtin_amdgcn_readfirstlane(tid >> 6);
                    if (it < 16) { for (int rr = 0; rr <= REP(8); ++rr) cscan_item<128, true>(li, 32 + ((it >> 2) & 1), it & 3, it >> 3, lds, tid, lane, wave); continue; } it -= 16;
                    if (it < 16) { for (int rr = 0; rr <= REP(9); ++rr) cscan_item<64, false>(li, 32 + ((it >> 2) & 1), it & 3, it >> 3, lds, tid, lane, wave); continue; } it -= 16;
                    if (it < 64) { if (EN(9)) hyena_mfma_item<0>(li, 1, it, 0, lds, tid, lane, wave); continue; } it -= 64;
                    if (it < 224) { const int kt = it % 7, r = it / 7, qb = r & 7, kvh = (r >> 3) & 1, b = r >> 4;
                        if ((kt == 4 && qb == 0) || (kt == 6 && qb == 7)) continue;
                        for (int rr = 0; rr <= REP(10); ++rr) attn_mfma_item(li, 32 + b, kvh, qb, kt, lds, tid, lane, wave); continue; } it -= 224;
                    if (it < 256) { for (int rr = 0; rr <= REP(8); ++rr) cscan_item<128, true>(li, it >> 3, (it >> 1) & 3, it & 1, lds, tid, lane, wave); continue; } it -= 256;
                    if (it < 256) { for (int rr = 0; rr <= REP(9); ++rr) cscan_item<64, false>(li, it >> 3, (it >> 1) & 3, it & 1, lds, tid, lane, wave); continue; } it -= 256;
                    if (it < 256) { for (int rr = 0; rr <= REP(10); ++rr) attn_mfma_item(li, it >> 3, (it >> 2) & 1, (it >> 1) & 1, it & 1, lds, tid, lane, wave); continue; } it -= 256;
                    if (EN(9)) hyena_mfma_item<0>(li, 0, it >> 2, it & 3, lds, tid, lane, wave);
                }
            } else if (k == 7) {
                for (;;) {
                    int it = dq_next(ctl + ph + 32 * rep, qslot, threadIdx.x);
                    if (it >= 1600) break;
                    int tid = threadIdx.x, li = (ph - 1) / 12; asm volatile("" : "+v"(tid)); asm volatile("" : "+s"(li));
                    const int lane = tid & 63, wave = __builtin_amdgcn_readfirstlane(tid >> 6);
                    if (it < 64) { if (EN(10)) hyena_mfma_item<1>(li, 1, it, 0, lds, tid, lane, wave); continue; } it -= 64;
                    if (it < 256) { if (EN(10)) hyena_mfma_item<1>(li, 0, it >> 2, it & 3, lds, tid, lane, wave); continue; } it -= 256;
                    for (int rr = 0; rr <= REP(12); ++rr) finalize_token(li, it * 8 + wave, lane);
                }
            }
        }
        }
        if (ph + 1 < ph_hi) {
            if (ph == 0) cg::this_grid().sync();
            else xcd_barrier((unsigned*)(AWS() + WS_CTL) + CW_BAR, (volatile LAS unsigned*)((LAS unsigned char*)lds + 131072 + 128));
        }
    }

}

extern "C" void kernel_launch(void* const* d_in, const int* in_sizes, int n_in, void* d_out, int out_size, void* d_ws, size_t ws_size, hipStream_t stream) {
    static int grid = 0;
    if (grid == 0) {
        if (n_in != 35 || ws_size < WS_END) { fprintf(stderr, "kernel_launch: unexpected n_in %d / ws %zu\n", n_in, ws_size); grid = -1; return; }
        int dev = 0, cus = 0, per_cu = 0;
        hipGetDevice(&dev);
        hipDeviceGetAttribute(&cus, hipDeviceAttributeMultiprocessorCount, dev);
        if (hipFuncSetAttribute((const void*)mk_fwd, hipFuncAttributeMaxDynamicSharedMemorySize, LDS_BYTES) != hipSuccess) { fprintf(stderr, "kernel_launch: hipFuncSetAttribute failed\n"); grid = -1; return; }
        if (hipOccupancyMaxActiveBlocksPerMultiprocessor(&per_cu, (const void*)mk_fwd, NTHR, LDS_BYTES) != hipSuccess || per_cu < 1) { fprintf(stderr, "kernel_launch: occupancy query says %d\n", per_cu); per_cu = 1; }
        (void)hipGetLastError();
        if (per_cu > 1) per_cu = 1;
        grid = cus * per_cu;
    }
    if (grid < 0) return;
    hipMemsetAsync((char*)d_ws + WS_CTL, 0, CTL_ZERO_BYTES, stream);
    Args a{};
    for (int i = 0; i < 35; ++i) a.in[i] = (const float*)d_in[i];
    a.out = (float*)d_out; a.ws = (unsigned char*)d_ws;
#if MK_MULTI
    for (int ph = 0; ph < NPHASE; ++ph) { a.ph_lo = ph; a.ph_hi = ph + 1; hipLaunchKernelGGL(mk_fwd, dim3(grid), dim3(NTHR), LDS_BYTES, stream, a); }
#else
    a.ph_lo = 0; a.ph_hi = NPHASE + (MK_KEEP != 0x3F ? 1 : 0);
    void* args[] = {&a};
    hipError_t e = hipLaunchCooperativeKernel((const void*)mk_fwd, dim3(grid), dim3(NTHR), args, LDS_BYTES, stream);
    if (e != hipSuccess) fprintf(stderr, "cooperative launch failed: %s (grid %d)\n", hipGetErrorString(e), grid);
#endif
}
```

```cpp
#include <hip/hip_runtime.h>
#include <hip/hip_cooperative_groups.h>
#include <cstdio>
#include <cstdint>
namespace cg = cooperative_groups;

#ifndef MK_EN
#define MK_EN 0xFFFF
#endif
#define EN(b) ((MK_EN >> (b)) & 1)
#ifndef MK_KEEP
#define MK_KEEP 0x3F
#endif
#ifndef MK_REP
#define MK_REP 0
#endif
#define REP(b) ((MK_REP >> (b)) & 1)
#ifndef MK_MULTI
#define MK_MULTI 0
#endif

#define GAS __attribute__((address_space(1)))
#define LAS __attribute__((address_space(3)))
typedef unsigned short bf16;
typedef float f32x4 __attribute__((ext_vector_type(4)));
typedef float f32x2 __attribute__((ext_vector_type(2)));
typedef unsigned u32x4 __attribute__((ext_vector_type(4)));
typedef unsigned u32x2 __attribute__((ext_vector_type(2)));
typedef unsigned short u16x4 __attribute__((ext_vector_type(4)));

namespace pg8 {
#define PG8_LAS __attribute__((address_space(3)))
typedef unsigned short bf16_t;
typedef short bf16x8 __attribute__((ext_vector_type(8)));
constexpr int BM = 256, BK = 64, HALF = 128, HTB = HALF * BK * 2, STAGE_BYTES = 8 * HTB, NXCD = 8, WGM = 8;

__host__ __device__ __forceinline__ int lds_byte(int r, int c) { const int st = (r >> 4) * 2 + (c >> 5), rr = r & 15, cc = c & 31, ob = rr * 64 + cc * 2; return st * 1024 + (ob ^ (((ob >> 9) & 1) << 5)); }
__host__ __device__ __forceinline__ void stage_rc(int b, int& R, int& C) { const int st = b / 1024, sb = b % 1024, swz = sb ^ (((sb >> 9) & 1) << 5); R = (st >> 1) * 16 + swz / 64; C = (st & 1) * 32 + (swz % 64) / 2; }
__host__ __device__ __forceinline__ int perm32(int rho) { const int n = rho >> 4, i = rho & 15; return 8 * (i >> 2) + 4 * n + (i & 3); }

struct Unit { int pm, pn; };
struct Gemm { const bf16_t* A; const bf16_t* Bt; int M, N, K; };

struct StaticOrder {
    int nM, nN, nwg, G, c;
    __host__ __device__ void init(int M, int N, int G_, int c_) { nM = M / BM; nN = N / BM; nwg = nM * nN; G = G_; c = c_; }
    __host__ __device__ bool next(int i, Unit& u) const {
        const long L = (long)i * G + c; if (L >= nwg) return false;
        int wgid = (int)L; { const int q = nwg / NXCD, r = nwg % NXCD, xcd = wgid % NXCD, off = wgid / NXCD; wgid = (xcd < r ? xcd * (q + 1) : r * (q + 1) + (xcd - r) * q) + off; }
        const int nig = WGM * nN, gid = wgid / nig, fm = gid * WGM, gsz = (nM - fm) < WGM ? (nM - fm) : WGM;
        u.pm = fm + ((wgid % nig) % gsz); u.pn = (wgid % nig) / gsz; return true;
    }
    __device__ __forceinline__ void a_ready(const Unit&) const {}
    __device__ __forceinline__ void done(const Unit&) const {}
};

__device__ __forceinline__ unsigned cvt_pk_bf16(float lo, float hi) { unsigned r; asm volatile("v_cvt_pk_bf16_f32 %0, %1, %2" : "=v"(r) : "v"(lo), "v"(hi)); return r; }
__device__ __forceinline__ float silu_f(float v) { return v * __builtin_amdgcn_rcpf(1.0f + __expf(-v)); }

struct EpiSwiglu {
    static constexpr bool PERM = true, AFTER_DRAIN = false;
    bf16_t* O; int ldc;
    __device__ __forceinline__ void operator()(const f32x4 (&acc)[2][2][4][2], const Unit& u, int wr, int wc, int fr, int fq) const {
        const int row0 = u.pm * BM + wr * 64 + fr, col0 = u.pn * HALF + wc * 32 + 8 * fq;
#pragma unroll
        for (int ai = 0; ai < 2; ++ai)
#pragma unroll
            for (int m = 0; m < 4; ++m) { bf16_t* rowp = O + (size_t)(row0 + ai * HALF + m * 16) * ldc + col0;
                const f32x4 g0 = acc[ai][0][m][0], g1 = acc[ai][0][m][1], u0 = acc[ai][1][m][0], u1 = acc[ai][1][m][1];
                u32x4 w;
                w.x = cvt_pk_bf16(silu_f(g0[0]) * u0[0], silu_f(g0[1]) * u0[1]); w.y = cvt_pk_bf16(silu_f(g0[2]) * u0[2], silu_f(g0[3]) * u0[3]);
                w.z = cvt_pk_bf16(silu_f(g1[0]) * u1[0], silu_f(g1[1]) * u1[1]); w.w = cvt_pk_bf16(silu_f(g1[2]) * u1[2], silu_f(g1[3]) * u1[3]);
                *(u32x4*)rowp = w; }
    }
};
struct EpiBf16 {
    static constexpr bool PERM = true, AFTER_DRAIN = false;
    bf16_t* O; int ldc;
    __device__ __forceinline__ void operator()(const f32x4 (&acc)[2][2][4][2], const Unit& u, int wr, int wc, int fr, int fq) const {
        const int row0 = u.pm * BM + wr * 64 + fr, col0 = u.pn * BM + wc * 32 + 8 * fq;
#pragma unroll
        for (int ai = 0; ai < 2; ++ai)
#pragma unroll
            for (int m = 0; m < 4; ++m) { bf16_t* rowp = O + (size_t)(row0 + ai * HALF + m * 16) * ldc + col0;
#pragma unroll
                for (int bj = 0; bj < 2; ++bj) { const f32x4 v0 = acc[ai][bj][m][0], v1 = acc[ai][bj][m][1];
                    u32x4 w; w.x = cvt_pk_bf16(v0[0], v0[1]); w.y = cvt_pk_bf16(v0[2], v0[3]); w.z = cvt_pk_bf16(v1[0], v1[1]); w.w = cvt_pk_bf16(v1[2], v1[3]);
                    *(u32x4*)(rowp + bj * HALF) = w; } }
    }
};
struct EpiResid {
    static constexpr bool PERM = false, AFTER_DRAIN = false;
    const float* xin_ctx; const float* xin_lat; float* out; const float* gate; float scale;
    __device__ __forceinline__ void operator()(const f32x4 (&acc)[2][2][4][2], const Unit& u, int wr, int wc, int fr, int fq) const {
        const int row0 = u.pm * BM + wr * 64 + fr, col0 = u.pn * BM + wc * 32 + 4 * fq;
        const int cidx = u.pm < 32 ? 0 : 1 + ((u.pm - 32) >> 2);
        const float* xin = u.pm < 32 ? xin_ctx : xin_lat;
        const float* gp = gate + cidx * 9216 + col0;
        f32x4 gv[2][2];
#pragma unroll
        for (int bj = 0; bj < 2; ++bj)
#pragma unroll
            for (int n = 0; n < 2; ++n) gv[bj][n] = *(const f32x4*)(gp + bj * HALF + n * 16) * scale;
#pragma unroll
        for (int ai = 0; ai < 2; ++ai)
#pragma unroll
            for (int m = 0; m < 4; ++m) { const size_t off = (size_t)(row0 + ai * HALF + m * 16) * 1024 + col0;
#pragma unroll
                for (int bj = 0; bj < 2; ++bj)
#pragma unroll
                    for (int n = 0; n < 2; ++n) { const f32x4 xv = *(const f32x4*)(xin + off + bj * HALF + n * 16);
                        *(f32x4*)(out + off + bj * HALF + n * 16) = xv + gv[bj][n] * acc[ai][bj][m][n]; } }
    }
};

template <class Epi, class Sched, bool ALIGN_EPI = false, bool SP2 = false>
__device__ __forceinline__ void gemm_phase(PG8_LAS unsigned char* lds, const Gemm g, const Sched& S, const Epi& E, const int tid) {
    const int wid = __builtin_amdgcn_readfirstlane(tid >> 6), lane = tid & 63, wr = wid >> 2, wc = wid & 3, fr = lane & 15, fq = lane >> 4;
    const int K = g.K, nt = K / BK;
    unsigned voffA[2], voffB[2];
#pragma unroll
    for (int i = 0; i < 2; ++i) { int R, C; stage_rc(tid * 16 + i * 8192, R, C); const int Rb = Epi::PERM ? ((R & ~31) + perm32(R & 31)) : R;
        voffA[i] = (unsigned)(R * K + C) * 2u; voffB[i] = (unsigned)(Rb * K + C) * 2u; }
    const size_t kstep = (size_t)(BK * 2);
    const size_t hstep = (size_t)HALF * K * 2;
    const size_t tstep = 2 * hstep;
    const unsigned ldsw = (unsigned)wid * 1024u;
    const int aoff = lds_byte(wr * 64 + fr, fq * 8), boff = lds_byte(wc * 32 + fr, fq * 8);
#define PG8_SA(b, h) (((b) * 2 + (h)) * HTB)
#define PG8_SB(b, h) ((4 + (b) * 2 + (h)) * HTB)
#define PG8_STAGE(bufoff, gbase, voff) do { _Pragma("unroll") for (int _i = 0; _i < 2; ++_i) \
        __builtin_amdgcn_global_load_lds((const unsigned*)((const char*)(gbase) + (voff)[_i]), (PG8_LAS unsigned*)(lds + (bufoff) + ldsw + _i * 8192), 16, 0, 0); } while (0)
#define PG8_LDA(dst, b, h) do { _Pragma("unroll") for (int m = 0; m < 4; ++m) _Pragma("unroll") for (int k = 0; k < 2; ++k) dst[m][k] = *(const PG8_LAS bf16x8*)(lds + PG8_SA(b, h) + aoff + m * 2048 + k * 1024); } while (0)
#define PG8_LDB(dst, b, h) do { _Pragma("unroll") for (int n = 0; n < 2; ++n) _Pragma("unroll") for (int k = 0; k < 2; ++k) dst[n][k] = *(const PG8_LAS bf16x8*)(lds + PG8_SB(b, h) + boff + n * 2048 + k * 1024); } while (0)
#define PG8_MMA(ai, bj, At, Bt) do { __builtin_amdgcn_s_setprio(1); _Pragma("unroll") for (int m = 0; m < 4; ++m) _Pragma("unroll") for (int n = 0; n < 2; ++n) _Pragma("unroll") for (int k = 0; k < 2; ++k) \
        acc[ai][bj][m][n] = __builtin_amdgcn_mfma_f32_16x16x32_bf16(Bt[n][k], At[m][k], acc[ai][bj][m][n], 0, 0, 0); __builtin_amdgcn_s_setprio(0); } while (0)
#define PG8_WAIT_V(n) asm volatile("s_waitcnt vmcnt(" #n ")" ::: "memory")
#define PG8_WAIT_L(n) asm volatile("s_waitcnt lgkmcnt(" #n ")" ::: "memory")
#define PG8_BAR __builtin_amdgcn_s_barrier()
#define PG8_SCHED __builtin_amdgcn_sched_barrier(0)
    Unit cur, nxt; int ui = 0;
    if (!S.next(0, cur)) return;
    f32x4 acc[2][2][4][2];
#pragma unroll
    for (int a = 0; a < 2; ++a)
#pragma unroll
        for (int b = 0; b < 2; ++b)
#pragma unroll
            for (int m = 0; m < 4; ++m)
#pragma unroll
                for (int n = 0; n < 2; ++n) acc[a][b][m][n] = (f32x4){0.f, 0.f, 0.f, 0.f};
    bf16x8 At[4][2], B0[2][2], B1[2][2];
    const char* cA = (const char*)g.A + (size_t)cur.pm * tstep; const char* cB = (const char*)g.Bt + (size_t)cur.pn * tstep;
    S.a_ready(cur);
    if constexpr (SP2) {
        PG8_STAGE(PG8_SB(0, 0), cB, voffB); PG8_STAGE(PG8_SB(0, 1), cB + hstep, voffB); PG8_STAGE(PG8_SA(0, 0), cA, voffA); PG8_STAGE(PG8_SA(0, 1), cA + hstep, voffA);
        if (wr == 1) PG8_BAR;
        PG8_WAIT_V(2); PG8_BAR;
        PG8_STAGE(PG8_SB(1, 0), cB + kstep, voffB); PG8_STAGE(PG8_SA(1, 0), cA + kstep, voffA); PG8_STAGE(PG8_SB(1, 1), cB + hstep + kstep, voffB);
        PG8_WAIT_V(6); PG8_BAR;
    } else {
        PG8_STAGE(PG8_SB(0, 0), cB, voffB); PG8_STAGE(PG8_SA(0, 0), cA, voffA); PG8_STAGE(PG8_SB(0, 1), cB + hstep, voffB); PG8_STAGE(PG8_SA(0, 1), cA + hstep, voffA);
        if (wr == 1) PG8_BAR;
        PG8_WAIT_V(4); PG8_BAR;
        PG8_STAGE(PG8_SB(1, 0), cB + kstep, voffB); PG8_STAGE(PG8_SA(1, 0), cA + kstep, voffA); PG8_STAGE(PG8_SB(1, 1), cB + hstep + kstep, voffB);
        PG8_WAIT_V(6); PG8_BAR;
    }
    for (;;) {
        const bool has_next = S.next(ui + 1, nxt);
        const char* nA = has_next ? (const char*)g.A + (size_t)nxt.pm * tstep : cA; const char* nB = has_next ? (const char*)g.Bt + (size_t)nxt.pn * tstep : cB;
        for (int t = 0; t < nt; t += 2) {
            const bool last = (t == nt - 2);
            const char* a1 = cA + (size_t)(t + 1) * kstep;
            const char* a2 = last ? nA : cA + (size_t)(t + 2) * kstep; const char* b2 = last ? nB : cB + (size_t)(t + 2) * kstep;
            const char* a3 = a2 + kstep; const char* b3 = b2 + kstep;
            if (last && has_next) S.a_ready(nxt);
            if constexpr (SP2) {
            PG8_LDB(B0, 0, 0); PG8_LDB(B1, 0, 1); PG8_SCHED; PG8_LDA(At, 0, 0); PG8_STAGE(PG8_SA(1, 1), a1 + hstep, voffA);
            PG8_WAIT_V(8); PG8_WAIT_L(0); PG8_BAR; PG8_MMA(0, 0, At, B0); PG8_MMA(0, 1, At, B1); PG8_BAR; PG8_SCHED;
            PG8_LDA(At, 0, 1); PG8_STAGE(PG8_SB(0, 0), b2, voffB); PG8_STAGE(PG8_SB(0, 1), b2 + hstep, voffB); PG8_STAGE(PG8_SA(0, 0), a2, voffA);
            PG8_WAIT_V(8); PG8_WAIT_L(0); PG8_BAR; PG8_MMA(1, 0, At, B0); PG8_MMA(1, 1, At, B1); PG8_BAR; PG8_SCHED;
            PG8_LDB(B0, 1, 0); PG8_LDB(B1, 1, 1); PG8_SCHED; PG8_LDA(At, 1, 0); PG8_STAGE(PG8_SA(0, 1), a2 + hstep, voffA);
            PG8_WAIT_V(8); PG8_WAIT_L(0); PG8_BAR; PG8_MMA(0, 0, At, B0); PG8_MMA(0, 1, At, B1); PG8_BAR; PG8_SCHED;
            PG8_LDA(At, 1, 1); PG8_STAGE(PG8_SB(1, 0), b3, voffB); PG8_STAGE(PG8_SB(1, 1), b3 + hstep, voffB); PG8_STAGE(PG8_SA(1, 0), a3, voffA);
            PG8_WAIT_V(8); PG8_WAIT_L(0); PG8_BAR; PG8_MMA(1, 0, At, B0); PG8_MMA(1, 1, At, B1); PG8_BAR; PG8_SCHED;
            } else {
            PG8_LDB(B0, 0, 0); PG8_SCHED; PG8_LDA(At, 0, 0); PG8_STAGE(PG8_SA(1, 1), a1 + hstep, voffA);
            PG8_WAIT_L(8); PG8_BAR; PG8_WAIT_L(0); PG8_MMA(0, 0, At, B0); PG8_BAR; PG8_SCHED;
            PG8_LDB(B1, 0, 1); PG8_STAGE(PG8_SB(0, 0), b2, voffB);
            PG8_BAR; PG8_WAIT_L(0); PG8_MMA(0, 1, At, B1); PG8_BAR;
            PG8_LDA(At, 0, 1); PG8_STAGE(PG8_SA(0, 0), a2, voffA);
            PG8_BAR; PG8_WAIT_L(0); PG8_MMA(1, 0, At, B0); PG8_BAR; PG8_SCHED;
            PG8_STAGE(PG8_SB(0, 1), b2 + hstep, voffB);
            PG8_WAIT_V(6); PG8_BAR; PG8_MMA(1, 1, At, B1); PG8_BAR;
            PG8_LDB(B0, 1, 0); PG8_SCHED; PG8_LDA(At, 1, 0); PG8_STAGE(PG8_SA(0, 1), a2 + hstep, voffA);
            PG8_WAIT_L(8); PG8_BAR; PG8_WAIT_L(0); PG8_MMA(0, 0, At, B0); PG8_BAR; PG8_SCHED;
            PG8_LDB(B1, 1, 1); PG8_STAGE(PG8_SB(1, 0), b3, voffB);
            PG8_BAR; PG8_WAIT_L(0); PG8_MMA(0, 1, At, B1); PG8_BAR;
            PG8_LDA(At, 1, 1); PG8_STAGE(PG8_SA(1, 0), a3, voffA);
            PG8_BAR; PG8_WAIT_L(0); PG8_MMA(1, 0, At, B0); PG8_BAR; PG8_SCHED;
            PG8_STAGE(PG8_SB(1, 1), b3 + hstep, voffB);
            PG8_WAIT_V(6); PG8_BAR; PG8_MMA(1, 1, At, B1); PG8_BAR;
            }
        }
        if constexpr (ALIGN_EPI) { if (wr == 0) PG8_BAR; }
        if constexpr (!Epi::AFTER_DRAIN) { E(acc, cur, wr, wc, fr, fq); S.done(cur); }
        if (!has_next) break;
#pragma unroll
        for (int a = 0; a < 2; ++a)
#pragma unroll
            for (int b = 0; b < 2; ++b)
#pragma unroll
                for (int m = 0; m < 4; ++m)
#pragma unroll
                    for (int n = 0; n < 2; ++n) acc[a][b][m][n] = (f32x4){0.f, 0.f, 0.f, 0.f};
        cur = nxt; cA = nA; cB = nB; ++ui;
        if constexpr (ALIGN_EPI) { if (wr == 1) PG8_BAR; }
    }
    PG8_WAIT_V(0);
    if constexpr (!ALIGN_EPI) { if (wr == 0) PG8_BAR; }
    PG8_BAR;
#undef PG8_SA
#undef PG8_SB
#undef PG8_STAGE
#undef PG8_LDA
#undef PG8_LDB
#undef PG8_MMA
#undef PG8_WAIT_V
#undef PG8_WAIT_L
#undef PG8_BAR
#undef PG8_SCHED
}
}

constexpr int NTHR = 512, NWAVES = 8;
constexpr int D = 1024, TCTX = 8192, TLAT = 2048, TT = 10240, DFF = 2816;
constexpr int DIN = 3336, DINP = 3584;
constexpr int U_Z = 0, U_XBC = 256, U_DT = 1024, U_HY = 1032, U_RET = 1800, U_ATT = 2824;
constexpr float EPS = 1e-6f;
constexpr int NPHASE = 25;

constexpr size_t MiB = 1u << 20;
constexpr size_t WS_CTL = 0, CTL_ZERO_BYTES = 65536;
constexpr int CW_BAR = 4096;
constexpr size_t WS_MOD = 1 * MiB;
constexpr size_t WS_HK = 2 * MiB, HK_LAYER = 6 * MiB, HK1024_OFF = 1310720;
constexpr size_t WS_W = 14 * MiB, W_LAYER = 42 * MiB;
constexpr size_t W_IN0 = 0, W_IN1 = 11 * MiB, W_OUT0 = 22 * MiB, W_OUT1 = 22 * MiB + 5767168, W_MI = 33 * MiB, W_MO = 40 * MiB;
constexpr size_t WS_H = 98 * MiB;
constexpr size_t WS_YMIX = 118 * MiB;
constexpr size_t WS_UA = 138 * MiB;
constexpr size_t WS_XBC = 208 * MiB;
constexpr size_t WS_SCAL = 223 * MiB;
constexpr size_t WS_QK = 238 * MiB;
constexpr size_t WS_YS = 253 * MiB;
constexpr size_t WS_YR = 273 * MiB;
constexpr size_t WS_Z1 = 293 * MiB;
constexpr size_t WS_APC = 303 * MiB;
constexpr size_t WS_APL = 320 * MiB;
constexpr size_t WS_END = 335 * MiB;
constexpr size_t APC_ML = (size_t)8192 * 4 * 2 * 64 * 4, APL_ML = (size_t)2048 * 4 * 7 * 64 * 4;

constexpr size_t O_Y = 0, O_CK = 10485760, O_CV = 12582912, O_SSD = 14680064, O_RET = 18874368;

constexpr int LDS_BYTES = 147456;

struct Args { const float* in[35]; float* out; unsigned char* ws; int ph_lo, ph_hi; };
typedef const __attribute__((address_space(4))) unsigned char* kargp_t;
__device__ __forceinline__ unsigned long long karg_u64(int off) { asm volatile("" : "+s"(off)); kargp_t kp = (kargp_t)__builtin_amdgcn_kernarg_segment_ptr(); return *(const __attribute__((address_space(4))) unsigned long long*)(kp + off); }
__device__ __forceinline__ int karg_i32(int off) { asm volatile("" : "+s"(off)); kargp_t kp = (kargp_t)__builtin_amdgcn_kernarg_segment_ptr(); return *(const __attribute__((address_space(4))) int*)(kp + off); }
#define INP(i) ((const float*)(const GAS float*)karg_u64(8 * (i)))
#define AOUT() ((float*)(GAS float*)karg_u64(8 * 35))
#define AWS() ((unsigned char*)(GAS unsigned char*)karg_u64(8 * 36))


#define LDS_WAIT() asm volatile("s_waitcnt lgkmcnt(0)" ::: "memory")
__device__ __forceinline__ float bf2f(unsigned short b) { return __uint_as_float(((unsigned)b) << 16); }
__device__ __forceinline__ unsigned f2bf(float f) { unsigned u = __float_as_uint(f); return (u + 0x7fffu + ((u >> 16) & 1u)) >> 16; }
__device__ __forceinline__ unsigned pk2(float lo, float hi) { return f2bf(lo) | (f2bf(hi) << 16); }
__device__ __forceinline__ float wave_sum(float v) {
#pragma unroll
    for (int o = 1; o < 64; o <<= 1) v += __shfl_xor(v, o);
    return v;
}
__device__ __forceinline__ float siluf(float v) { return v / (1.0f + __expf(-v)); }
__device__ __forceinline__ void seq_info(int sq, int& L, int& base) { if (sq < 32) { L = 256; base = sq * 256; } else { L = 1024; base = TCTX + (sq - 32) * 1024; } }

__device__ __forceinline__ void transpose_item(const float* __restrict__ W, int K, int Nsrc, bf16* WT, int k0, int n0, int drow0, LAS float* scr, int lane) {
    const int nn = n0 + (lane & 31); const bool ok = nn < Nsrc;
    float tv[32];
#pragma unroll
    for (int i = 0; i < 32; ++i) { const int kk = 2 * i + (lane >> 5); tv[i] = ok ? W[(size_t)(k0 + kk) * Nsrc + nn] : 0.f; }
#pragma unroll
    for (int i = 0; i < 32; ++i) { const int kk = 2 * i + (lane >> 5); scr[kk * 33 + (lane & 31)] = tv[i]; }
    LDS_WAIT();
    const int c = lane & 7;
#pragma unroll
    for (int j = 0; j < 4; ++j) { const int n = (lane >> 3) + 8 * j; const LAS float* s = scr + (8 * c) * 33 + n;
        u32x4 o; o.x = pk2(s[0 * 33], s[1 * 33]); o.y = pk2(s[2 * 33], s[3 * 33]); o.z = pk2(s[4 * 33], s[5 * 33]); o.w = pk2(s[6 * 33], s[7 * 33]);
        *(u32x4*)(WT + (size_t)(drow0 + n) * K + k0 + 8 * c) = o; }
    LDS_WAIT();
}

__device__ __forceinline__ void transpose_jobs(int lo, int hi, int gwl, int ngwl, unsigned char* lds, int lane, int wave) {
    LAS float* scr = (LAS float*)((LAS unsigned char*)lds + wave * 16384);
    constexpr int I_IN = 16 * 176, I_OUT = 44 * 32, I_MI = 16 * 112, I_MO = 16 * 32, I_LAYER = 2 * I_IN + 2 * I_OUT + I_MI + I_MO;
    for (int it = lo + gwl; it < hi; it += ngwl) {
        const int l = it / I_LAYER; int r = it % I_LAYER;
        unsigned char* wl = AWS() + WS_W + (size_t)l * W_LAYER;
        int f = 0;
        if (r >= I_IN + I_OUT + I_MI + I_MO) { r -= I_IN + I_OUT + I_MI + I_MO; f = 1; }
        else if (r >= I_IN + I_OUT) {
            r -= I_IN + I_OUT;
            if (r < I_MI) { const int kb = r / 112, nb = r % 112;
                transpose_item(INP(13) + (size_t)l * 1024 * DIN, 1024, DIN, (bf16*)(wl + W_MI), kb * 64, nb * 32, nb * 32, scr, lane); }
            else { r -= I_MI; const int kb = r / 32, nb = r % 32;
                transpose_item(INP(14) + (size_t)l * 1024 * 1024, 1024, 1024, (bf16*)(wl + W_MO), kb * 64, nb * 32, nb * 32, scr, lane); }
            continue; }
        if (r < I_IN) { const int kb = r / 176, nb = r % 176, n0 = nb * 32;
            const int isup = n0 >= DFF, ff = isup ? n0 - DFF : n0; const int drow0 = (ff >> 7) * 256 + isup * 128 + (ff & 127);
            transpose_item(INP(11) + (size_t)(l * 2 + f) * 1024 * 5632, 1024, 5632, (bf16*)(wl + (f ? W_IN1 : W_IN0)), kb * 64, n0, drow0, scr, lane); }
        else { r -= I_IN; const int kb = r / 32, nb = r % 32;
            transpose_item(INP(12) + (size_t)(l * 2 + f) * 2816 * 1024, 2816, 1024, (bf16*)(wl + (f ? W_OUT1 : W_OUT0)), kb * 64, nb * 32, nb * 32, scr, lane); }
    }
}

__device__ __forceinline__ void p0_gemv_item(int it, unsigned char* lds, int tid, int lane, int wave) {
    const float* cc = INP(6); const float* cctx = INP(7); const float* wmod = INP(8); const float* bmod = INP(9);
    float* mod = (float*)(AWS() + WS_MOD);
    float* sc = (float*)lds;
    float* red = sc + 3072;
    __syncthreads();
    for (int i = tid; i < 3072; i += NTHR) { const int ci = i >> 10, k = i & 1023; const float v = ci == 0 ? cctx[k] : cc[(ci - 1) * 1024 + k]; sc[i] = siluf(v); }
    __syncthreads();
    const int l = it / 36, col = (it % 36) * 256 + 4 * lane;
    const float* wp = wmod + ((size_t)l * 1024 + wave * 128) * 9216 + col;
    f32x4 a0 = (f32x4){0.f, 0.f, 0.f, 0.f}, a1 = a0, a2 = a0;
#pragma unroll 16
    for (int k = 0; k < 128; ++k) { const f32x4 w = *(const f32x4*)(wp + (size_t)k * 9216); const int kk = wave * 128 + k; a0 += w * sc[kk]; a1 += w * sc[1024 + kk]; a2 += w * sc[2048 + kk]; }
    *(f32x4*)(red + (wave * 3 + 0) * 256 + 4 * lane) = a0; *(f32x4*)(red + (wave * 3 + 1) * 256 + 4 * lane) = a1; *(f32x4*)(red + (wave * 3 + 2) * 256 + 4 * lane) = a2;
    __syncthreads();
    for (int o = tid; o < 768; o += NTHR) { const int ci = o >> 8, cl = o & 255; float sum = bmod[l * 9216 + (it % 36) * 256 + cl];
#pragma unroll
        for (int w = 0; w < 8; ++w) sum += red[(w * 3 + ci) * 256 + cl];
        mod[((size_t)l * 3 + ci) * 9216 + (it % 36) * 256 + cl] = sum; }
}
__device__ __forceinline__ void p0_filter_item(int it, unsigned char* lds, int tid) {
    float* fl = (float*)lds;
    float* feats = fl;
    float* h1 = fl + 512;
    float* h2 = fl + 1024;
    const float MIN_DECAY = -3.0701134573253945f, MAX_DECAY = -15.350567286626973f;
    const int l = it / 160, r = it % 160; const int L = r < 32 ? 256 : 1024; const int pg = r < 32 ? r : r - 32;
    const float* w1 = INP(23) + l * 33 * 64; const float* b1 = INP(24) + l * 64; const float* w2 = INP(25) + l * 64 * 64; const float* b2 = INP(26) + l * 64;
    const float* w3 = INP(27) + (size_t)l * 64 * 1024; const float* fr = INP(28) + l * 64; const float* hb = INP(29) + l * 512;
    float* Hk = (float*)(AWS() + WS_HK + (size_t)l * HK_LAYER + (L == 256 ? 0 : HK1024_OFF));
    __syncthreads();
    if (tid < 8 * 33) { const int pl = tid / 33, j = tid % 33; const float pos = (float)(pg * 8 + pl); float f;
        if (j == 0) f = pos / (float)(L - 1);
        else { const int b = (j - 1) & 15; const float band = 1e-4f + (float)b * ((15.0f - 1e-4f) / 15.0f); const float ang = (6.283185307179586f / (float)L) * pos * band; f = j <= 16 ? cosf(ang) : -sinf(ang); }
        feats[pl * 36 + j] = f; }
    __syncthreads();
    { const int pl = tid >> 6, j = tid & 63; float sacc = b1[j];
        for (int k = 0; k < 33; ++k) sacc += feats[pl * 36 + k] * w1[k * 64 + j];
        h1[pl * 64 + j] = sinf(fr[j] * sacc); }
    __syncthreads();
    { const int pl = tid >> 6, j = tid & 63; float sacc = b2[j];
#pragma unroll 8
        for (int k = 0; k < 64; ++k) sacc += h1[pl * 64 + k] * w2[k * 64 + j];
        h2[pl * 64 + j] = sinf(fr[j] * sacc); }
    __syncthreads();
    float acc[2][8];
#pragma unroll
    for (int cc = 0; cc < 2; ++cc)
#pragma unroll
        for (int p = 0; p < 8; ++p) acc[cc][p] = 0.f;
#pragma unroll 8
    for (int k = 0; k < 64; ++k) { const float wa = w3[k * 1024 + tid], wb = w3[k * 1024 + 512 + tid];
#pragma unroll
        for (int p = 0; p < 8; ++p) { const float hv = h2[p * 64 + k]; acc[0][p] += hv * wa; acc[1][p] += hv * wb; } }
#pragma unroll
    for (int cc = 0; cc < 2; ++cc) {
        const int col = tid + cc * 512;
        const int c = col & 255, o = (col >> 8) & 1, dir = col >> 9;
        const float delta = fabsf(MIN_DECAY + (float)c * ((MAX_DECAY - MIN_DECAY) / 255.0f));
        float* Ho = Hk + (size_t)o * (2 * L - 1) * 256 + c;
#pragma unroll
        for (int p = 0; p < 8; ++p) { const int pos = pg * 8 + p; const float t = (float)pos / (float)(L - 1);
            float v = acc[cc][p] * __expf(-t * delta);
            if (dir == 0) { if (pos == 0) v += hb[o * 256 + c]; Ho[(size_t)(L - 1 + pos) * 256] = v; }
            else if (pos > 0) Ho[(size_t)(L - 1 - pos) * 256] = v; }
    }
}

__device__ __forceinline__ void prep_phase(const float* xc, const float* xl, const float* nw, const float* modl, int p, bf16* H, int gw, int NGW, int lane) {
    f32x4 wv[4];
#pragma unroll
    for (int j = 0; j < 4; ++j) wv[j] = *(const f32x4*)(nw + 4 * lane + 256 * j);
    for (int row = gw; row < TT; row += NGW) {
        const float* x = (row < TCTX ? xc : xl) + (size_t)row * D;
        const int cidx = row < TCTX ? 0 : 1 + ((row - TCTX) >> 10);
        const float* sh = modl + (size_t)cidx * 9216 + (3 * p) * 1024; const float* sc = sh + 1024;
        f32x4 v[4]; float ss = 0.f;
#pragma unroll
        for (int j = 0; j < 4; ++j) { v[j] = *(const f32x4*)(x + 4 * lane + 256 * j); ss += (v[j].x * v[j].x + v[j].y * v[j].y) + (v[j].z * v[j].z + v[j].w * v[j].w); }
        const float rstd = rsqrtf(wave_sum(ss) * (1.0f / D) + EPS);
#pragma unroll
        for (int j = 0; j < 4; ++j) { const f32x4 s1 = *(const f32x4*)(sc + 4 * lane + 256 * j), s0 = *(const f32x4*)(sh + 4 * lane + 256 * j);
            const f32x4 y = (v[j] * rstd * wv[j]) * (s1 + 1.0f) + s0;
            u32x2 o; o.x = pk2(y.x, y.y); o.y = pk2(y.z, y.w);
            *(u32x2*)(H + (size_t)row * D + 4 * lane + 256 * j) = o; }
    }
}

__device__ __forceinline__ void m1_phase(int li, int gw, int NGW, int lane) {
    const bf16* U = (const bf16*)(AWS() + WS_UA);
    bf16* XBC = (bf16*)(AWS() + WS_XBC); float* QK = (float*)(AWS() + WS_QK);
    const float* cw = INP(15) + li * 3 * 768; const float* cb = INP(16) + li * 768;
    f32x4 w0[3], w1[3], w2[3], wb[3];
#pragma unroll
    for (int i = 0; i < 3; ++i) { const int ch = 256 * i + 4 * lane; w0[i] = *(const f32x4*)(cw + ch); w1[i] = *(const f32x4*)(cw + 768 + ch); w2[i] = *(const f32x4*)(cw + 1536 + ch); wb[i] = *(const f32x4*)(cb + ch); }
    const int dl = 4 * (lane & 15);
    const f32x4 qw4 = *(const f32x4*)(INP(32) + li * 64 + dl), kw4 = *(const f32x4*)(INP(33) + li * 64 + dl);
    const int hfd = (lane & 15) >> 3;
    const bool lowhalf = ((lane & 7) < 4);
    float inv[4];
#pragma unroll
    for (int e = 0; e < 4; ++e) inv[e] = exp2f(-(float)((dl + e) & 15) * (13.287712379549449f / 16.0f));
    for (int tok = gw; tok < TT; tok += NGW) {
        int sq, pos, L;
        if (tok < TCTX) { sq = tok >> 8; pos = tok & 255; L = 256; } else { sq = 32 + ((tok - TCTX) >> 10); pos = (tok - TCTX) & 1023; L = 1024; }
        const bf16* ur = U + (size_t)tok * DINP;
        const bool hasl = pos > 0, hasr = pos < L - 1;
        u16x4 c0[3], cm[3], cp[3];
#pragma unroll
        for (int i = 0; i < 3; ++i) { const int ch = U_XBC + 256 * i + 4 * lane; c0[i] = *(const u16x4*)(ur + ch);
            cm[i] = hasl ? *(const u16x4*)(ur + ch - DINP) : (u16x4){0, 0, 0, 0}; cp[i] = hasr ? *(const u16x4*)(ur + ch + DINP) : (u16x4){0, 0, 0, 0}; }
        const u16x4 qa = *(const u16x4*)(ur + U_ATT + 4 * lane);
        const u16x4 ka = (lane < 32) ? *(const u16x4*)(ur + U_ATT + 256 + 4 * lane) : (u16x4){0, 0, 0, 0};
        const u16x4 va = (lane < 32) ? *(const u16x4*)(ur + U_ATT + 384 + 4 * lane) : (u16x4){0, 0, 0, 0};
#pragma unroll
        for (int i = 0; i < 3; ++i) { f32x4 v;
#pragma unroll
            for (int e = 0; e < 4; ++e) v[e] = siluf(wb[i][e] + w0[i][e] * bf2f(cm[i][e]) + w1[i][e] * bf2f(c0[i][e]) + w2[i][e] * bf2f(cp[i][e]));
            u32x2 o; o.x = pk2(v[0], v[1]); o.y = pk2(v[2], v[3]); *(u32x2*)(XBC + (size_t)tok * 768 + 256 * i + 4 * lane) = o; }
        float sn[4] = {0.f, 0.f, 0.f, 0.f}, cs[4] = {1.f, 1.f, 1.f, 1.f};
        if (sq >= 32) { const float pv = hfd ? (float)(pos & 63) : (float)(pos >> 6);
#pragma unroll
            for (int e = 0; e < 4; ++e) sincosf(pv * inv[e], &sn[e], &cs[e]); }
#pragma unroll
        for (int part = 0; part < 2; ++part) {
            const u16x4 raw = part ? ka : qa; const f32x4 nw4 = part ? kw4 : qw4;
            f32x4 x = (f32x4){bf2f(raw[0]), bf2f(raw[1]), bf2f(raw[2]), bf2f(raw[3])};
            float ss = (x[0] * x[0] + x[1] * x[1]) + (x[2] * x[2] + x[3] * x[3]);
            ss += __shfl_xor(ss, 1); ss += __shfl_xor(ss, 2); ss += __shfl_xor(ss, 4); ss += __shfl_xor(ss, 8);
            const float rs = rsqrtf(ss * (1.0f / 64.0f) + EPS);
            f32x4 y = x * rs * nw4;
            if (part == 1 && sq < 32 && lane < 32) *(f32x4*)(AOUT() + O_CK + ((((size_t)sq * 2 + li) * 256 + pos) * 2 + (lane >> 4)) * 64 + dl) = y;
            if (sq >= 32) {
#pragma unroll
                for (int e = 0; e < 4; ++e) { const float yp = __shfl_xor(y[e], 4); y[e] = lowhalf ? y[e] * cs[e] - yp * sn[e] : yp * sn[e] + y[e] * cs[e]; }
            }
            if (part == 0) *(f32x4*)(QK + (size_t)tok * 384 + 4 * lane) = y;
            else if (lane < 32) *(f32x4*)(QK + (size_t)tok * 384 + 256 + 4 * lane) = y;
        }
        if (sq < 32 && lane < 32) *(f32x4*)(AOUT() + O_CV + ((((size_t)sq * 2 + li) * 256 + pos) * 2 + (lane >> 4)) * 64 + dl) = (f32x4){bf2f(va[0]), bf2f(va[1]), bf2f(va[2]), bf2f(va[3])};
    }
}

__device__ __forceinline__ void ssd_scalars(int li, int gw, int NGW, int lane) {
    const bf16* U = (const bf16*)(AWS() + WS_UA); float* SCG = (float*)(AWS() + WS_SCAL);
    for (int job = gw; job < 640; job += NGW) {
        const int cg = job >> 2, h = job & 3;
        const float dtb_f = INP(17)[(li * 2 + 0) * 4 + h], dtb_b = INP(17)[(li * 2 + 1) * 4 + h], an_f = -__expf(INP(18)[(li * 2 + 0) * 4 + h]), an_b = -__expf(INP(18)[(li * 2 + 1) * 4 + h]);
        const bf16* up = U + ((size_t)cg * 64 + lane) * DINP + U_DT + h;
        const float xf = bf2f(up[0]) + dtb_f, xb = bf2f(up[4]) + dtb_b;
        const float dtf = xf > 20.f ? xf : log1pf(__expf(xf)), dtbk = xb > 20.f ? xb : log1pf(__expf(xb));
        float cf = dtf * an_f, rc = dtbk * an_b;
#pragma unroll
        for (int o = 1; o < 64; o <<= 1) { const float t1 = __shfl_up(cf, o), t2 = __shfl_down(rc, o); if (lane >= o) cf += t1; if (lane + o < 64) rc += t2; }
        const float cfl = __shfl(cf, 63), rc0 = __shfl(rc, 0);
        float* o = SCG + (size_t)job * 576;
        o[lane] = cf; o[64 + lane] = rc; o[128 + lane] = dtf; o[192 + lane] = dtbk;
        o[256 + lane] = dtf * __expf(cfl - cf); o[320 + lane] = dtbk * __expf(rc0 - rc);
        o[384 + lane] = __expf(cf); o[448 + lane] = __expf(rc);
        if (lane == 0) { o[512] = __expf(cfl); o[513] = __expf(rc0); o[514] = 0.f; o[515] = 0.f; }
    }
}

typedef short sbf16x8 __attribute__((ext_vector_type(8)));
typedef float sf32x16 __attribute__((ext_vector_type(16)));
#define SC_MFMA(a, b, c) __builtin_amdgcn_mfma_f32_32x32x16_bf16((a), (b), (c), 0, 0, 0)
template <int N, bool SSD>
__device__ __forceinline__ void cscan_item(int li, int sq, int h, int pass, unsigned char* lds, int tid, int lane, int wave) {
    constexpr int RS = N + 8, TS = 72;
    constexpr int O_CQ = 0, O_BK = O_CQ + 64 * RS * 2, O_BKT = O_BK + 64 * RS * 2, O_VT = O_BKT + N * TS * 2, O_VWT = O_VT + 64 * TS * 2, O_ST = O_VWT + 64 * TS * 2,
                  O_YX = O_ST + 64 * RS * 2, O_SC = O_YX + 16384;
    static_assert(O_SC + 4096 <= 131072, "chunk scan LDS");
    constexpr int GR = 2 * (N / 8) + 8, R = (64 * GR) / NTHR;
    static_assert((64 * GR) % NTHR == 0, "chunk loader");
    int L, base; seq_info(sq, L, base);
    const int nch = L >> 6, g = h >> 1;
    const bf16* src = SSD ? (const bf16*)(AWS() + WS_XBC) : (const bf16*)(AWS() + WS_UA);
    const int sstr = SSD ? 768 : DINP;
    const int qoff = SSD ? 512 + g * 128 : U_RET + h * 64, koff = SSD ? 256 + g * 128 : U_RET + 256 + h * 64, voff = SSD ? h * 64 : U_RET + 512 + h * 64;
    float* Yout = (float*)(AWS() + (SSD ? WS_YS : WS_YR)) + (size_t)pass * TT * 256;
    const float* SCG = (const float*)(AWS() + WS_SCAL) + ((size_t)(base >> 6) * 4 + h) * 576;
    float* sc = (float*)(lds + O_SC);
    const int r = lane & 31, hh = lane >> 5;
    const bool has_state = SSD || wave < 4;
    const int nt = SSD ? (wave & 3) : (wave & 1), pt_s = SSD ? (wave >> 2) : ((wave >> 1) & 1);
    const int it = wave & 1, pt = (wave >> 1) & 1, kh = wave >> 2;
    uint4 pre[R]; f32x4 scv = (f32x4){0.f, 0.f, 0.f, 0.f}; float wj = 0.f;
    __syncthreads();
    if (!SSD) {
        const float d0 = INP(30)[(li * 2 + 0) * 4 + h], d1 = INP(30)[(li * 2 + 1) * 4 + h];
        const float lgf = -log1pf(__expf(-d0)), lgb = -log1pf(__expf(-d1));
        if (tid < 64) { const float cf = (float)(tid + 1) * lgf, rc = (float)(64 - tid) * lgb;
            sc[tid] = cf; sc[64 + tid] = rc; sc[128 + tid] = 0.125f; sc[192 + tid] = 0.125f;
            sc[256 + tid] = 0.125f * __expf((float)(63 - tid) * lgf); sc[320 + tid] = 0.125f * __expf((float)tid * lgb);
            sc[384 + tid] = __expf(cf); sc[448 + tid] = __expf(rc);
            if (tid == 0) { sc[512] = __expf(64.f * lgf); sc[513] = __expf(64.f * lgb); } }
        wj = 0.125f * (pass ? __expf((float)(tid & 63) * lgb) : __expf((float)(63 - (tid & 63)) * lgf));
    }
    sf32x16 accS;
    if (has_state) {
        if (sq < 32) {
#pragma unroll
            for (int i = 0; i < 16; ++i) accS[i] = 0.f;
        } else {
            const float* s0 = INP(SSD ? 4 : 5) + ((((size_t)(sq - 32) * 2 + li) * 2 + pass) * 4 + h) * (size_t)(N * 64);
#pragma unroll
            for (int i = 0; i < 16; ++i) accS[i] = s0[(32 * nt + (i & 3) + 8 * (i >> 2) + 4 * hh) * 64 + 32 * pt_s + r];
        }
    }
    auto issue = [&](int c) {
#pragma unroll
        for (int q = 0; q < R; ++q) { const int gi0 = tid + NTHR * q, j = gi0 & 63, gi = gi0 >> 6; const size_t tok = (size_t)base + c * 64 + j;
            const int col = gi < N / 8 ? qoff + 8 * gi : (gi < N / 4 ? koff + 8 * (gi - N / 8) : voff + 8 * (gi - N / 4));
            pre[q] = *(const uint4*)(src + tok * sstr + col); }
        if (SSD) { const float* scc = SCG + (size_t)c * (4 * 576); wj = scc[(pass ? 320 : 256) + (tid & 63)]; if (tid < 129) scv = *(const f32x4*)(scc + 4 * tid); }
    };
    issue(pass ? nch - 1 : 0);
    for (int cc = 0; cc < nch; ++cc) {
        const int c = pass ? nch - 1 - cc : cc;
        {
#pragma unroll
            for (int q = 0; q < R; ++q) { const int gi0 = tid + NTHR * q, j = gi0 & 63, gi = gi0 >> 6; const uint4 v = pre[q];
                if (gi < N / 8) { *(uint4*)(lds + O_CQ + (j * RS + 8 * gi) * 2) = v; }
                else if (gi < N / 4) { const int n0 = 8 * (gi - N / 8);
                    if (pass == 0) *(uint4*)(lds + O_BK + (j * RS + n0) * 2) = v;
                    bf16* bt = (bf16*)(lds + O_BKT) + n0 * TS + j; const unsigned w[4] = {v.x, v.y, v.z, v.w};
#pragma unroll
                    for (int e = 0; e < 4; ++e) { bt[(2 * e) * TS] = (bf16)(w[e] & 0xffffu); bt[(2 * e + 1) * TS] = (bf16)(w[e] >> 16); } }
                else { const int p0 = 8 * (gi - N / 4);
                    bf16* vt = (bf16*)(lds + O_VT) + p0 * TS + j; bf16* vw = (bf16*)(lds + O_VWT) + p0 * TS + j; const unsigned w[4] = {v.x, v.y, v.z, v.w};
#pragma unroll
                    for (int e = 0; e < 4; ++e) { const bf16 lo = (bf16)(w[e] & 0xffffu), hi = (bf16)(w[e] >> 16);
                        if (pass == 0) { vt[(2 * e) * TS] = lo; vt[(2 * e + 1) * TS] = hi; }
                        vw[(2 * e) * TS] = (bf16)f2bf(bf2f(lo) * wj); vw[(2 * e + 1) * TS] = (bf16)f2bf(bf2f(hi) * wj); } }
            }
            if (SSD && tid < 129) *(f32x4*)(sc + 4 * tid) = scv;
            if (has_state) { bf16* st = (bf16*)(lds + O_ST) + (32 * pt_s + r) * RS + 32 * nt + 4 * hh;
#pragma unroll
                for (int gq = 0; gq < 4; ++gq) { u32x2 o; o.x = pk2(accS[4 * gq], accS[4 * gq + 1]); o.y = pk2(accS[4 * gq + 2], accS[4 * gq + 3]); *(u32x2*)(st + 8 * gq) = o; } }
        }
        if (cc + 1 < nch) issue(pass ? c - 1 : c + 1);
        __syncthreads();
        sf32x16 accY, accQ;
#pragma unroll
        for (int i = 0; i < 16; ++i) { accY[i] = 0.f; accQ[i] = 0.f; }
        if (pass == 0) {
            sf32x16 gt;
#pragma unroll
            for (int i = 0; i < 16; ++i) gt[i] = 0.f;
            const unsigned char* ap = lds + O_BK + ((32 * kh + r) * RS + 8 * hh) * 2; const unsigned char* bp = lds + O_CQ + ((32 * it + r) * RS + 8 * hh) * 2;
#pragma unroll
            for (int s2 = 0; s2 < N / 16; ++s2) gt = SC_MFMA(*(const sbf16x8*)(ap + 32 * s2), *(const sbf16x8*)(bp + 32 * s2), gt);
            const float cfi = sc[32 * it + r], rci = sc[64 + 32 * it + r];
            float m[16];
#pragma unroll
            for (int e = 0; e < 16; ++e) { const int jl = (e & 3) + 8 * (e >> 2) + 4 * hh, j = 32 * kh + jl;
                float f = 0.f;
                if (kh < it || (kh == it && jl <= r)) f = sc[128 + j] * __expf(cfi - sc[j]);
                if (kh > it || (kh == it && jl >= r)) f += sc[192 + j] * __expf(rci - sc[64 + j]);
                m[e] = gt[e] * f; }
            const unsigned char* vp = lds + O_VT + ((32 * pt + r) * TS + 32 * kh + 4 * hh) * 2;
#pragma unroll
            for (int s2 = 0; s2 < 2; ++s2) {
                u32x4 av; av.x = pk2(m[8 * s2 + 0], m[8 * s2 + 1]); av.y = pk2(m[8 * s2 + 2], m[8 * s2 + 3]); av.z = pk2(m[8 * s2 + 4], m[8 * s2 + 5]); av.w = pk2(m[8 * s2 + 6], m[8 * s2 + 7]);
                const u32x2 b0 = *(const u32x2*)(vp + (16 * s2) * 2), b1 = *(const u32x2*)(vp + (16 * s2 + 8) * 2);
                u32x4 bv; bv.x = b0.x; bv.y = b0.y; bv.z = b1.x; bv.w = b1.y;
                accY = SC_MFMA(__builtin_bit_cast(sbf16x8, av), __builtin_bit_cast(sbf16x8, bv), accY);
            }
        }
        {
            const unsigned char* ap = lds + O_CQ + ((32 * it + r) * RS + (N / 2) * kh + 8 * hh) * 2; const unsigned char* bp = lds + O_ST + ((32 * pt + r) * RS + (N / 2) * kh + 8 * hh) * 2;
#pragma unroll
            for (int s2 = 0; s2 < N / 32; ++s2) accQ = SC_MFMA(*(const sbf16x8*)(ap + 32 * s2), *(const sbf16x8*)(bp + 32 * s2), accQ);
        }
        {
            const float* esc = sc + (pass ? 448 : 384) + 32 * it + 4 * hh;
#pragma unroll
            for (int e = 0; e < 16; ++e) accY[e] += esc[(e & 3) + 8 * (e >> 2)] * accQ[e];
        }
        float* yx = (float*)(lds + O_YX) + (it + 2 * pt) * 1024;
        if (kh == 1) {
#pragma unroll
            for (int e = 0; e < 16; ++e) yx[e * 64 + lane] = accY[e];
        }
        if (has_state) {
            const float dA = sc[512 + pass];
#pragma unroll
            for (int i = 0; i < 16; ++i) accS[i] *= dA;
            const unsigned char* ap = lds + O_BKT + ((32 * nt + r) * TS + 8 * hh) * 2; const unsigned char* bp = lds + O_VWT + ((32 * pt_s + r) * TS + 8 * hh) * 2;
#pragma unroll
            for (int s2 = 0; s2 < 4; ++s2) accS = SC_MFMA(*(const sbf16x8*)(ap + 32 * s2), *(const sbf16x8*)(bp + 32 * s2), accS);
        }
        __syncthreads();
        if (kh == 0) {
            float* yo = Yout + ((size_t)base + c * 64 + 32 * it + 4 * hh) * 256 + h * 64 + 32 * pt + r;
#pragma unroll
            for (int e = 0; e < 16; ++e) yo[(size_t)((e & 3) + 8 * (e >> 2)) * 256] = accY[e] + yx[e * 64 + lane];
        }
    }
    if (has_state && sq < 32) {
        float* so = AOUT() + (SSD ? O_SSD : O_RET) + ((((size_t)sq * 2 + li) * 2 + pass) * 4 + h) * (size_t)(N * 64);
#pragma unroll
        for (int i = 0; i < 16; ++i) so[(32 * nt + (i & 3) + 8 * (i >> 2) + 4 * hh) * 64 + 32 * pt_s + r] = accS[i];
    }
}

__device__ __forceinline__ void attn_item(int li, int sq, int kvh, int qb, int kt, unsigned char* lds, int tid, int lane, int wave) {
    int L, base; seq_info(sq, L, base);
    const bool lat = sq >= 32;
    const float* QK = (const float*)(AWS() + WS_QK); const bf16* U = (const bf16*)(AWS() + WS_UA);
    float* Ks = (float*)lds; float* Vs = Ks + 128 * 64;
    const int kb = qb + kt - 5;
    __syncthreads();
#pragma unroll
    for (int r = 0; r < 4; ++r) { const int e = tid + NTHR * r, j = e >> 4, c4 = (e & 15) * 4;
        f32x4 kq, vq;
        if (lat && kt < 4) { const size_t ci = ((((size_t)(sq - 32) * 2 + li) * 512 + kt * 128 + j) * 2 + kvh) * 64 + c4; kq = *(const f32x4*)(INP(2) + ci); vq = *(const f32x4*)(INP(3) + ci); }
        else { const size_t tok = (size_t)base + (lat ? kb : kt) * 128 + j; kq = *(const f32x4*)(QK + tok * 384 + 256 + kvh * 64 + c4);
            const u16x4 w = *(const u16x4*)(U + tok * DINP + U_ATT + 384 + kvh * 64 + c4); vq = (f32x4){bf2f(w.x), bf2f(w.y), bf2f(w.z), bf2f(w.w)}; }
        *(f32x4*)(Ks + j * 64 + c4) = kq; *(f32x4*)(Vs + j * 64 + c4) = vq; }
    const int pair = tid & 255, khalf = tid >> 8, qi = pair & 127, hh = pair >> 7, head = kvh * 2 + hh;
    const size_t qtok = (size_t)base + qb * 128 + qi;
    f32x4 q[16], o[16];
#pragma unroll
    for (int i = 0; i < 16; ++i) { q[i] = *(const f32x4*)(QK + qtok * 384 + head * 64 + 4 * i) * 0.125f; o[i] = (f32x4){0.f, 0.f, 0.f, 0.f}; }
    float m = -1e30f, l = 0.f;
    __syncthreads();
    const bool masked = lat && kt >= 4;
    const int qpos = qb * 128 + qi;
    for (int jj = 0; jj < 64; ++jj) {
        const int j = khalf * 64 + jj;
        f32x4 sa = (f32x4){0.f, 0.f, 0.f, 0.f};
#pragma unroll
        for (int i = 0; i < 16; ++i) sa += q[i] * *(const f32x4*)(Ks + j * 64 + 4 * i);
        const float s = (sa.x + sa.y) + (sa.z + sa.w);
        bool valid = true;
        if (masked) { const int d = qpos - (kb * 128 + j); valid = (d <= 128) && (d >= -128); }
        if (valid) {
            if (s > m) { const float corr = __expf(m - s); l *= corr;
#pragma unroll
                for (int i = 0; i < 16; ++i) o[i] *= corr;
                m = s; }
            const float pexp = __expf(s - m); l += pexp;
#pragma unroll
            for (int i = 0; i < 16; ++i) o[i] += pexp * *(const f32x4*)(Vs + j * 64 + 4 * i);
        }
    }
    __syncthreads();
    float* mg = (float*)lds + pair * 68;
    if (khalf == 1) { mg[0] = m; mg[1] = l;
#pragma unroll
        for (int i = 0; i < 16; ++i) *(f32x4*)(mg + 4 + 4 * i) = o[i]; }
    __syncthreads();
    if (khalf == 0) { const float m1 = mg[0], l1 = mg[1]; const float M = fmaxf(m, m1), c0 = __expf(m - M), c1 = __expf(m1 - M);
        mg[0] = M; mg[1] = l * c0 + l1 * c1;
#pragma unroll
        for (int i = 0; i < 16; ++i) { const f32x4 o1 = *(const f32x4*)(mg + 4 + 4 * i); *(f32x4*)(mg + 4 + 4 * i) = o[i] * c0 + o1 * c1; } }
    __syncthreads();
    float* OP = (float*)(AWS() + (lat ? WS_APL : WS_APC)); float* MLp = (float*)(AWS() + (lat ? WS_APL + APL_ML : WS_APC + APC_ML));
    const int NS = lat ? 7 : 2; const size_t tb = lat ? (size_t)(base - TCTX) : (size_t)base;
    for (int pr = wave * 32; pr < wave * 32 + 32; ++pr) { const int qq = pr & 127, hd = kvh * 2 + (pr >> 7);
        const size_t idx = ((tb + qb * 128 + qq) * 4 + hd) * NS + kt; const float* src = (const float*)lds + pr * 68;
        OP[idx * 64 + lane] = src[4 + lane];
        if (lane < 2) MLp[idx * 2 + lane] = src[lane]; }
}


__device__ __forceinline__ void attn_mfma_item(int li, int sq, int kvh, int qb, int kt, unsigned char* lds, int tid, int lane, int wave) {
    constexpr int KSTR = 72, VSTR = 136, O_KS = 0, O_VTS = 128 * KSTR * 2;
    int L, base; seq_info(sq, L, base);
    const bool lat = sq >= 32;
    const float* QK = (const float*)(AWS() + WS_QK); const bf16* U = (const bf16*)(AWS() + WS_UA);
    const int kb = qb + kt - 5;
    __syncthreads();
#pragma unroll
    for (int q = 0; q < 4; ++q) { const int gI = tid + NTHR * q, key = gI & 127, d4 = (gI >> 7) * 4;
        f32x4 kq, vq;
        if (lat && kt < 4) { const size_t ci = ((((size_t)(sq - 32) * 2 + li) * 512 + kt * 128 + key) * 2 + kvh) * 64 + d4; kq = *(const f32x4*)(INP(2) + ci); vq = *(const f32x4*)(INP(3) + ci); }
        else { const size_t tok = (size_t)base + (lat ? kb : kt) * 128 + key; kq = *(const f32x4*)(QK + tok * 384 + 256 + kvh * 64 + d4);
            const u16x4 w = *(const u16x4*)(U + tok * DINP + U_ATT + 384 + kvh * 64 + d4); vq = (f32x4){bf2f(w.x), bf2f(w.y), bf2f(w.z), bf2f(w.w)}; }
        u32x2 kw; kw.x = pk2(kq.x, kq.y); kw.y = pk2(kq.z, kq.w);
        *(u32x2*)(lds + O_KS + (key * KSTR + d4) * 2) = kw;
        bf16* vt = (bf16*)(lds + O_VTS) + d4 * VSTR + key;
        vt[0] = (bf16)f2bf(vq.x); vt[VSTR] = (bf16)f2bf(vq.y); vt[2 * VSTR] = (bf16)f2bf(vq.z); vt[3 * VSTR] = (bf16)f2bf(vq.w); }
    const int r = lane & 31, hh = lane >> 5, head = kvh * 2 + (wave >> 2), q0 = 32 * (wave & 3);
    const size_t qtok = (size_t)base + qb * 128 + q0 + r;
    sbf16x8 qf[4];
#pragma unroll
    for (int s2 = 0; s2 < 4; ++s2) { const float* qp = QK + qtok * 384 + head * 64 + 16 * s2 + 8 * hh; const f32x4 a0 = *(const f32x4*)qp * 0.125f, a1 = *(const f32x4*)(qp + 4) * 0.125f;
        u32x4 w; w.x = pk2(a0.x, a0.y); w.y = pk2(a0.z, a0.w); w.z = pk2(a1.x, a1.y); w.w = pk2(a1.z, a1.w); qf[s2] = __builtin_bit_cast(sbf16x8, w); }
    __syncthreads();
    sf32x16 st[4];
#pragma unroll
    for (int t4 = 0; t4 < 4; ++t4) {
#pragma unroll
        for (int i = 0; i < 16; ++i) st[t4][i] = 0.f;
        const unsigned char* ap = lds + O_KS + ((32 * t4 + r) * KSTR + 8 * hh) * 2;
#pragma unroll
        for (int s2 = 0; s2 < 4; ++s2) st[t4] = SC_MFMA(*(const sbf16x8*)(ap + 32 * s2), qf[s2], st[t4]);
    }
    const bool masked = lat && kt >= 4;
    const int qpos = qb * 128 + q0 + r;
    float m = -1e30f;
#pragma unroll
    for (int t4 = 0; t4 < 4; ++t4)
#pragma unroll
        for (int e = 0; e < 16; ++e) { if (masked) { const int d = qpos - (kb * 128 + 32 * t4 + (e & 3) + 8 * (e >> 2) + 4 * hh); if (d > 128 || d < -128) st[t4][e] = -1e30f; }
            m = fmaxf(m, st[t4][e]); }
    m = fmaxf(m, __shfl_xor(m, 32));
    float l = 0.f;
#pragma unroll
    for (int t4 = 0; t4 < 4; ++t4)
#pragma unroll
        for (int e = 0; e < 16; ++e) { const float p = __expf(st[t4][e] - m); st[t4][e] = p; l += p; }
    l += __shfl_xor(l, 32);
    sf32x16 o0, o1;
#pragma unroll
    for (int i = 0; i < 16; ++i) { o0[i] = 0.f; o1[i] = 0.f; }
#pragma unroll
    for (int t4 = 0; t4 < 4; ++t4)
#pragma unroll
        for (int s2 = 0; s2 < 2; ++s2) {
            u32x4 av; av.x = pk2(st[t4][8 * s2 + 0], st[t4][8 * s2 + 1]); av.y = pk2(st[t4][8 * s2 + 2], st[t4][8 * s2 + 3]); av.z = pk2(st[t4][8 * s2 + 4], st[t4][8 * s2 + 5]); av.w = pk2(st[t4][8 * s2 + 6], st[t4][8 * s2 + 7]);
            const sbf16x8 a8 = __builtin_bit_cast(sbf16x8, av);
            const unsigned char* vp = lds + O_VTS + (r * VSTR + 32 * t4 + 16 * s2 + 4 * hh) * 2;
            { const u32x2 b0 = *(const u32x2*)vp, b1 = *(const u32x2*)(vp + 16); u32x4 bv; bv.x = b0.x; bv.y = b0.y; bv.z = b1.x; bv.w = b1.y; o0 = SC_MFMA(a8, __builtin_bit_cast(sbf16x8, bv), o0); }
            { const u32x2 b0 = *(const u32x2*)(vp + 32 * VSTR * 2), b1 = *(const u32x2*)(vp + 32 * VSTR * 2 + 16); u32x4 bv; bv.x = b0.x; bv.y = b0.y; bv.z = b1.x; bv.w = b1.y; o1 = SC_MFMA(a8, __builtin_bit_cast(sbf16x8, bv), o1); }
        }
    float* OP = (float*)(AWS() + (lat ? WS_APL : WS_APC)); float* MLp = (float*)(AWS() + (lat ? WS_APL + APL_ML : WS_APC + APC_ML));
    const int NS = lat ? 7 : 2; const size_t tb = lat ? (size_t)(base - TCTX) : (size_t)base;
#pragma unroll
    for (int e = 0; e < 16; ++e) { const int qr = (e & 3) + 8 * (e >> 2) + 4 * hh; const size_t idx = ((tb + qb * 128 + q0 + qr) * 4 + head) * NS + kt;
        OP[idx * 64 + r] = o0[e]; OP[idx * 64 + 32 + r] = o1[e]; }
    if (hh == 0) { const size_t idx = ((tb + qb * 128 + q0 + r) * 4 + head) * NS + kt; *(f32x2*)(MLp + idx * 2) = (f32x2){m, l}; }
}

typedef short hbf16x8 __attribute__((ext_vector_type(8)));
typedef float f32x16 __attribute__((ext_vector_type(16)));
constexpr int HY_FIL = 0, HY_Z = 32768, HY_XG = 49152, HY_ZERO = 65536;
template <int ORDER>
__device__ __forceinline__ void hyena_mfma_item(int li, int lat, int cq, int sgp, unsigned char* lds, int tid, int lane, int wave) {
    const int L = lat ? 1024 : 256, T = L >> 5, c0 = cq * 4;
    const float* Hk = (const float*)(AWS() + WS_HK + (size_t)li * HK_LAYER + (lat ? HK1024_OFF : 0)) + (size_t)ORDER * (2 * L - 1) * 256 + c0;
    const bf16* U = (const bf16*)(AWS() + WS_UA); bf16* Z1T = (bf16*)(AWS() + WS_Z1);
    const float* cw = INP(21) + li * 3 * 768; const float* cb = INP(22) + li * 768;
    bf16* FIL = (bf16*)(lds + HY_FIL); bf16* Zs = (bf16*)(lds + HY_Z); bf16* XG = (bf16*)(lds + HY_XG);
    __syncthreads();
    for (int lam = tid; lam < 2 * L - 1; lam += NTHR) {
        const f32x4 f = *(const f32x4*)(Hk + (size_t)lam * 256); const int x = 2 * L - 2 - lam;
#pragma unroll
        for (int ch = 0; ch < 4; ++ch) { const bf16 v = (bf16)f2bf(f[ch]); FIL[(ch * 2 + 0) * 2048 + x] = v; if (x >= 1) FIL[(ch * 2 + 1) * 2048 + x - 1] = v; }
    }
    if (tid < 8) ((unsigned*)(lds + HY_ZERO))[tid] = 0u;
    const int cz = c0, cg = 256 * (ORDER + 1) + c0;
    float wz[3][4], bz[4], wg[3][4], bg[4];
#pragma unroll
    for (int ch = 0; ch < 4; ++ch) { bz[ch] = cb[cz + ch]; bg[ch] = cb[cg + ch];
#pragma unroll
        for (int i = 0; i < 3; ++i) { wz[i][ch] = cw[i * 768 + cz + ch]; wg[i][ch] = cw[i * 768 + cg + ch]; } }
#pragma unroll
    for (int q = 0; q < 4; ++q) {
        const int p = tid + NTHR * q, sg2 = p >> 10, t = p & 1023, pos = t & (L - 1);
        const size_t tok = (size_t)(lat ? TCTX : 0) + (size_t)(sgp * 2 + sg2) * 1024 + t;
        const bf16* ur = U + tok * DINP + U_HY;
        const bool hasl = pos > 0, hasr = pos < L - 1;
        const u16x4 g0 = *(const u16x4*)(ur + cg), gl = hasl ? *(const u16x4*)(ur + cg - DINP) : (u16x4){0, 0, 0, 0}, gr = hasr ? *(const u16x4*)(ur + cg + DINP) : (u16x4){0, 0, 0, 0};
        u16x4 z0 = (u16x4){0, 0, 0, 0}, zl = z0, zr = z0;
        if (ORDER == 0) { z0 = *(const u16x4*)(ur + cz); if (hasl) zl = *(const u16x4*)(ur + cz - DINP); if (hasr) zr = *(const u16x4*)(ur + cz + DINP); }
#pragma unroll
        for (int ch = 0; ch < 4; ++ch) {
            const float gv = bg[ch] + wg[0][ch] * bf2f(gl[ch]) + wg[1][ch] * bf2f(g0[ch]) + wg[2][ch] * bf2f(gr[ch]);
            XG[(ch * 2 + sg2) * 1024 + t] = (bf16)f2bf(gv);
            bf16 zv;
            if (ORDER == 0) zv = (bf16)f2bf(bz[ch] + wz[0][ch] * bf2f(zl[ch]) + wz[1][ch] * bf2f(z0[ch]) + wz[2][ch] * bf2f(zr[ch]));
            else zv = Z1T[(size_t)(c0 + ch) * TT + tok];
            Zs[(ch * 2 + sg2) * 1024 + t] = zv;
        }
    }
    __syncthreads();
    const int chl = wave & 3, sg2 = wave >> 2;
    const int a = lane & 31, hh = lane >> 5, icol = lat ? a : (a & 7);
    const int par = (L - 1 - a) & 1;
    const LAS unsigned char* filb = (const LAS unsigned char*)lds + HY_FIL + (chl * 2 + par) * 4096 + 2 * ((L - 1) - a + 8 * hh - par);
    const LAS unsigned char* zb = (const LAS unsigned char*)lds + HY_Z + (chl * 2 + sg2) * 2048 + 2 * (32 * a + 8 * hh);
    const LAS unsigned char* zero = (const LAS unsigned char*)lds + HY_ZERO;
    f32x16 acc;
#pragma unroll
    for (int i = 0; i < 16; ++i) acc[i] = 0.f;
    for (int d = -(T - 1); d <= T - 1; ++d) {
        const int j = icol - d; const bool ok = (j >= 0) && (j < T);
#pragma unroll
        for (int kap = 0; kap < 2; ++kap) {
            const LAS unsigned* fp = (const LAS unsigned*)(filb + 2 * (16 * kap - 32 * d));
            u32x4 av; av.x = fp[0]; av.y = fp[1]; av.z = fp[2]; av.w = fp[3];
            const u32x4 bv = *(const LAS u32x4*)(ok ? zb + 2 * (16 * kap - 32 * d) : zero);
            acc = __builtin_amdgcn_mfma_f32_32x32x16_bf16(__builtin_bit_cast(hbf16x8, av), __builtin_bit_cast(hbf16x8, bv), acc, 0, 0, 0);
        }
    }
    const size_t tb = (size_t)(lat ? TCTX : 0) + (size_t)(sgp * 2 + sg2) * 1024;
    const bf16* xg = XG + (chl * 2 + sg2) * 1024 + 32 * a + 4 * hh;
#pragma unroll
    for (int g = 0; g < 4; ++g) {
        const u16x4 gq = *(const u16x4*)(xg + 8 * g);
        const float y0 = acc[4 * g + 0] * bf2f(gq.x), y1 = acc[4 * g + 1] * bf2f(gq.y), y2 = acc[4 * g + 2] * bf2f(gq.z), y3 = acc[4 * g + 3] * bf2f(gq.w);
        const size_t t = tb + 32 * a + 8 * g + 4 * hh;
        if (ORDER == 0) { u32x2 o; o.x = pk2(y0, y1); o.y = pk2(y2, y3); *(u32x2*)(Z1T + (size_t)(c0 + chl) * TT + t) = o; }
        else { bf16* ym = (bf16*)(AWS() + WS_YMIX) + t * D + 256 + c0 + chl; ym[0] = (bf16)f2bf(y0); ym[D] = (bf16)f2bf(y1); ym[2 * D] = (bf16)f2bf(y2); ym[3 * D] = (bf16)f2bf(y3); }
    }
}

__device__ __forceinline__ void finalize_token(int li, int tok, int lane) {
    const bf16* ur = (const bf16*)(AWS() + WS_UA) + (size_t)tok * DINP;
    bf16* ym = (bf16*)(AWS() + WS_YMIX) + (size_t)tok * D;
    const float* YS = (const float*)(AWS() + WS_YS); const float* YR = (const float*)(AWS() + WS_YR); const bf16* XBC = (const bf16*)(AWS() + WS_XBC);
    const int ch0 = lane * 4, hd = lane >> 4;
    {
        const f32x4 yf = *(const f32x4*)(YS + (size_t)tok * 256 + ch0), yb = *(const f32x4*)(YS + ((size_t)TT + tok) * 256 + ch0);
        const u16x4 xw = *(const u16x4*)(XBC + (size_t)tok * 768 + ch0); const f32x4 xs = (f32x4){bf2f(xw.x), bf2f(xw.y), bf2f(xw.z), bf2f(xw.w)};
        const u16x4 zw = *(const u16x4*)(ur + U_Z + ch0);
        const float dsk = INP(19)[li * 4 + hd];
        f32x4 y = yf + yb + xs * dsk;
        y.x *= siluf(bf2f(zw.x)); y.y *= siluf(bf2f(zw.y)); y.z *= siluf(bf2f(zw.z)); y.w *= siluf(bf2f(zw.w));
        const float ss = wave_sum((y.x * y.x + y.y * y.y) + (y.z * y.z + y.w * y.w));
        const float rstd = rsqrtf(ss * (1.0f / 256.0f) + EPS);
        const f32x4 nw = *(const f32x4*)(INP(20) + li * 256 + ch0);
        y = y * rstd * nw;
        u32x2 o; o.x = pk2(y.x, y.y); o.y = pk2(y.z, y.w); *(u32x2*)(ym + ch0) = o;
    }
    {
        const f32x4 yf = *(const f32x4*)(YR + (size_t)tok * 256 + ch0), yb = *(const f32x4*)(YR + ((size_t)TT + tok) * 256 + ch0);
        f32x4 y = yf + yb;
        float s = (y.x + y.y) + (y.z + y.w);
        s += __shfl_xor(s, 1); s += __shfl_xor(s, 2); s += __shfl_xor(s, 4); s += __shfl_xor(s, 8);
        const float mu = s * (1.0f / 64.0f);
        y = y - mu;
        float q = (y.x * y.x + y.y * y.y) + (y.z * y.z + y.w * y.w);
        q += __shfl_xor(q, 1); q += __shfl_xor(q, 2); q += __shfl_xor(q, 4); q += __shfl_xor(q, 8);
        const float rstd = rsqrtf(q * (1.0f / 64.0f) + EPS);
        const f32x4 gw = *(const f32x4*)(INP(31) + li * 256 + ch0);
        const u16x4 gg = *(const u16x4*)(ur + U_RET + 768 + ch0);
        y = y * rstd * gw;
        y.x *= siluf(bf2f(gg.x)); y.y *= siluf(bf2f(gg.y)); y.z *= siluf(bf2f(gg.z)); y.w *= siluf(bf2f(gg.w));
        u32x2 o; o.x = pk2(y.x, y.y); o.y = pk2(y.z, y.w); *(u32x2*)(ym + 512 + ch0) = o;
    }
    {
        const bool lat = tok >= TCTX;
        const float* OP = (const float*)(AWS() + (lat ? WS_APL : WS_APC)); const float* MLp = (const float*)(AWS() + (lat ? WS_APL + APL_ML : WS_APC + APC_ML));
        const int NS = lat ? 7 : 2; const size_t tb = lat ? (size_t)(tok - TCTX) : (size_t)tok;
        const int qb = lat ? (((tok - TCTX) & 1023) >> 7) : 0;
#pragma unroll
        for (int h = 0; h < 4; ++h) {
            const size_t idx = (tb * 4 + h) * NS;
            float ms = -1e30f, ls = 0.f;
            const bool sv = lane < NS && !(lat && ((lane == 4 && qb == 0) || (lane == 6 && qb == 7)));
            if (sv) { const f32x2 t = *(const f32x2*)(MLp + (idx + lane) * 2); ms = t.x; ls = t.y; }
            const float sink = INP(34)[li * 4 + h];
            float M = ms;
#pragma unroll
            for (int o = 1; o < 8; o <<= 1) M = fmaxf(M, __shfl_xor(M, o));
            M = fmaxf(M, sink);
            const float w = sv ? __expf(ms - M) : 0.f;
            float den = w * ls;
#pragma unroll
            for (int o = 1; o < 8; o <<= 1) den += __shfl_xor(den, o);
            den += __expf(sink - M);
            den = __shfl(den, 0);
            float ov = 0.f;
            for (int s = 0; s < NS; ++s) { const float ws_ = __shfl(w, s); if (ws_ != 0.f) ov += ws_ * OP[(idx + s) * 64 + lane]; }
            ym[768 + h * 64 + lane] = (bf16)f2bf(ov / den);
        }
    }
}


#define XB_TMO      128
#define XB_XCNT(j)  (256  + 64 * (j))
#define XB_XSUB(j)  (1280 + 64 * (j))
#define XB_XGEN(j)  (2304 + 64 * (j))
#define XB_TOP      3328
#define XB_TOPGEN   3392
#define XCD_BAR_WORDS 3456
#define XB_SPIN_CAP (1u << 18)
__device__ __forceinline__ unsigned xb_ld(unsigned* p)              { return __hip_atomic_load(p, __ATOMIC_RELAXED, __HIP_MEMORY_SCOPE_AGENT); }
__device__ __forceinline__ unsigned xb_add(unsigned* p, unsigned v) { return __hip_atomic_fetch_add(p, v, __ATOMIC_RELAXED, __HIP_MEMORY_SCOPE_AGENT); }
__device__ __forceinline__ unsigned xb_xcc_id() { return (unsigned)__builtin_amdgcn_s_getreg((3 << 11) | 20) & 0xFu; }
#define XB_SPIN(cond, bar) do { unsigned _sp = 0; while (cond) { __builtin_amdgcn_s_sleep(1); \
    if ((++_sp & 255u) == 0u) { if (xb_ld(&(bar)[XB_TMO])) break; if (_sp > XB_SPIN_CAP) { atomicAdd(&(bar)[XB_TMO], 1u); break; } } } } while (0)
__device__ __forceinline__ void xcd_barrier_complete(unsigned* bar, unsigned x, unsigned& nloc, unsigned& nx) {
    const unsigned G = gridDim.x * gridDim.y * gridDim.z;
    unsigned sum, cnt, mine, sp = 0u;
    for (;;) {
        sum = 0u; cnt = 0u; mine = 0u;
#pragma unroll
        for (unsigned j = 0; j < 16; ++j) { const unsigned c = xb_ld(&bar[XB_XCNT(j)]); sum += c; cnt += (c > 0u) ? 1u : 0u; mine = (j == x) ? c : mine; }
        if (sum == G) break;
        __builtin_amdgcn_s_sleep(1);
        if ((++sp & 255u) == 0u) { if (xb_ld(&bar[XB_TMO])) break; if (sp > XB_SPIN_CAP) { atomicAdd(&bar[XB_TMO], 1u); break; } }
    }
    nloc = mine > 0u ? mine : 1u; nx = cnt > 0u ? cnt : 1u;
}
__device__ __forceinline__ void xcd_barrier(unsigned* bar, volatile LAS unsigned* st) {
    asm volatile("s_waitcnt vmcnt(0)" ::: "memory");
    __syncthreads();
    if (threadIdx.x == 0) {
        const unsigned x = xb_xcc_id();
        __builtin_amdgcn_s_waitcnt(0);
        unsigned nloc = st[0], nx = st[1];
        if (nloc == 0u) { xcd_barrier_complete(bar, x, nloc, nx); st[0] = nloc; st[1] = nx; }
        const unsigned old = xb_add(&bar[XB_XSUB(x)], 1u);
        const unsigned gen = old / nloc;
        if (old + 1u == (gen + 1u) * nloc) {
            __builtin_amdgcn_fence(__ATOMIC_RELEASE, "agent");
            asm volatile("s_waitcnt vmcnt(0)" ::: "memory");
            const unsigned og = xb_add(&bar[XB_TOP], 1u);
            const unsigned tg = og / nx;
            if (og + 1u == (tg + 1u) * nx) xb_add(&bar[XB_TOPGEN], 1u);
            else XB_SPIN(xb_ld(&bar[XB_TOPGEN]) == tg, bar);
            __builtin_amdgcn_fence(__ATOMIC_ACQUIRE, "agent");
            xb_add(&bar[XB_XGEN(x)], 1u);
            asm volatile("s_waitcnt vmcnt(0)" ::: "memory");
        } else {
            XB_SPIN(xb_ld(&bar[XB_XGEN(x)]) == gen, bar);
            __builtin_amdgcn_fence(__ATOMIC_ACQUIRE, "agent");
            asm volatile("s_waitcnt vmcnt(0)" ::: "memory");
        }
    }
    __syncthreads();
}

__device__ __forceinline__ int dq_next(unsigned* ctr, volatile int* slot, int tid) {
    __syncthreads();
    if (tid == 0) *slot = (int)__hip_atomic_fetch_add(ctr, 1u, __ATOMIC_RELAXED, __HIP_MEMORY_SCOPE_AGENT);
    __syncthreads();
    return *slot;
}

__global__ void __launch_bounds__(NTHR, 2) mk_fwd(Args a) {
    extern __shared__ __attribute__((aligned(16))) unsigned char lds[];
    const int ph_hi = karg_i32(8 * 37 + 4);
    if (threadIdx.x < 64) ((volatile LAS unsigned*)((LAS unsigned char*)lds + 131072))[threadIdx.x] = 0u;
    __syncthreads();
    if (!MK_MULTI && threadIdx.x == 0) (void)xb_add((unsigned*)(AWS() + WS_CTL) + CW_BAR + XB_XCNT(xb_xcc_id()), 1u);
    for (int ph = karg_i32(8 * 37); ph < ph_hi; ++ph) {
        int nrep = 1;
        if (MK_REP) { const int k = (ph - 1) % 12;
            if (ph == 0) nrep += REP(0);
            else if (ph < NPHASE) nrep += (k == 0 || k == 3 || k == 9) ? REP(1) : (k == 1 || k == 10) ? REP(2) : (k == 2 || k == 8 || k == 11) ? REP(3) : k == 4 ? REP(4) : k == 5 ? REP(5) : k == 6 ? REP(6) : REP(7); }
        for (int rep = 0; rep < nrep; ++rep) {
        int tid = threadIdx.x; asm volatile("" : "+v"(tid));
        int G = gridDim.x, bid = blockIdx.x; asm volatile("" : "+s"(G), "+s"(bid));
        const int lane = tid & 63, wave = __builtin_amdgcn_readfirstlane(tid >> 6);
        const int gw = bid * NWAVES + wave, NGW = G * NWAVES;
        unsigned* ctl = (unsigned*)(AWS() + WS_CTL);
        volatile int* qslot = (volatile int*)(lds + 131072 + 64);
        float* xbuf = AOUT() + O_Y;
        if (rep) xcd_barrier((unsigned*)(AWS() + WS_CTL) + CW_BAR, (volatile LAS unsigned*)((LAS unsigned char*)lds + 131072 + 128));
        if (ph == 0) {
            for (;;) {
                int it = dq_next(ctl + ph + 32 * rep, qslot, threadIdx.x);
                if (it >= 72 + 320 + 528) break;
                int tid = threadIdx.x; asm volatile("" : "+v"(tid));
                const int lane = tid & 63, wave = __builtin_amdgcn_readfirstlane(tid >> 6);
                if (it < 72) { p0_gemv_item(it, lds, tid, lane, wave); continue; } it -= 72;
                if (it < 320) { p0_filter_item(it, lds, tid); continue; } it -= 320;
                __syncthreads();
                transpose_jobs(it * 8, it * 8 + 8, wave, 8, lds, lane, wave);
            }
        } else if (ph == NPHASE) {
            float* o = AOUT();
#define ZERO_OUT(i, lo, hi) if (!((MK_KEEP >> (i)) & 1)) for (size_t e = (size_t)(lo) + (size_t)bid * NTHR + tid; e < (size_t)(hi); e += (size_t)G * NTHR) o[e] = 0.f;
            ZERO_OUT(0, 0, 8388608) ZERO_OUT(1, 8388608, 10485760) ZERO_OUT(2, 10485760, 12582912) ZERO_OUT(3, 12582912, 14680064) ZERO_OUT(4, 14680064, 18874368) ZERO_OUT(5, 18874368, 20971520)
        } else {
            const int li = (ph - 1) / 12, k = (ph - 1) % 12;
            const float* modl = (const float*)(AWS() + WS_MOD) + (size_t)li * 3 * 9216;
            unsigned char* wl = AWS() + WS_W + (size_t)li * W_LAYER;
            const bool first = (li == 0 && k <= 2);
            const float* xc = first ? INP(0) : xbuf;
            const float* xl = first ? INP(1) - (size_t)TCTX * D : xbuf;
            if (k == 0 || k == 3 || k == 9) {
                const int p = k == 0 ? 0 : (k == 3 ? 1 : 2);
                if (EN(1)) prep_phase(xc, xl, INP(10) + (li * 3 + p) * 1024, modl, p, (bf16*)(AWS() + WS_H), gw, NGW, lane);
            } else if (k == 1 || k == 10) {
                pg8::Gemm g{(const bf16*)(AWS() + WS_H), (const bf16*)(wl + (k == 1 ? W_IN0 : W_IN1)), TT, 2 * DFF, D};
                pg8::StaticOrder S; S.init(TT, 2 * DFF, G, bid);
                pg8::EpiSwiglu E{(bf16*)(AWS() + WS_UA), DFF};
                if (EN(2)) pg8::gemm_phase<pg8::EpiSwiglu, pg8::StaticOrder, true, true>((LAS unsigned char*)lds, g, S, E, tid);
            } else if (k == 2 || k == 8 || k == 11) {
                const bool mix = (k == 8);
                pg8::Gemm g{(const bf16*)(AWS() + (mix ? WS_YMIX : WS_UA)), (const bf16*)(wl + (mix ? W_MO : (k == 2 ? W_OUT0 : W_OUT1))), TT, D, mix ? D : DFF};
                pg8::StaticOrder S; S.init(TT, D, G, bid);
                const int gi = k == 2 ? 2 : (k == 8 ? 5 : 8);
                pg8::EpiResid E{xc, xl, (rep + 1 < nrep) ? (float*)(AWS() + WS_XBC) : xbuf, modl + gi * 1024, mix ? 1.0f : 0.5f};
                if (EN(3)) pg8::gemm_phase<pg8::EpiResid, pg8::StaticOrder, true, true>((LAS unsigned char*)lds, g, S, E, tid);
                if (li == 0 && rep == 0 && bid >= 160 && G > 160) {
                    const int lo = k == 2 ? 4224 : (k == 8 ? 10752 : 10752 + 4224), hi = k == 2 ? 10752 : (k == 8 ? 10752 + 4224 : 21504);
                    transpose_jobs(lo, hi, (bid - 160) * NWAVES + wave, (G - 160) * NWAVES, lds, lane, wave);
                }
            } else if (k == 4) {
                pg8::Gemm g{(const bf16*)(AWS() + WS_H), (const bf16*)(wl + W_MI), TT, DINP, D};
                pg8::StaticOrder S; S.init(TT, DINP, G, bid);
                pg8::EpiBf16 E{(bf16*)(AWS() + WS_UA), DINP};
                if (EN(4)) pg8::gemm_phase<pg8::EpiBf16, pg8::StaticOrder, true, true>((LAS unsigned char*)lds, g, S, E, tid);
            } else if (k == 5) {
                if (EN(5)) { m1_phase(li, gw, NGW, lane); ssd_scalars(li, gw, NGW, lane); }
            } else if (k == 6) {
                for (;;) {
                    int it = dq_next(ctl + ph + 32 * rep, qslot, threadIdx.x);
                    if (it >= 1344) break;
                    int tid = threadIdx.x, li = (ph - 1) / 12; asm volatile("" : "+v"(tid)); asm volatile("" : "+s"(li));
                    const int lane = tid & 63, wave = __builtin_amdgcn_readfirstlane(tid >> 6);
                    if (it < 16) { for (int rr = 0; rr <= REP(8); ++rr) cscan_item<128, true>(li, 32 + ((it >> 2) & 1), it & 3, it >> 3, lds, tid, lane, wave); continue; } it -= 16;
                    if (it < 16) { for (int rr = 0; rr <= REP(9); ++rr) cscan_item<64, false>(li, 32 + ((it >> 2) & 1), it & 3, it >> 3, lds, tid, lane, wave); continue; } it -= 16;
                    if (it < 64) { if (EN(9)) hyena_mfma_item<0>(li, 1, it, 0, lds, tid, lane, wave); continue; } it -= 64;
                    if (it < 224) { const int kt = it % 7, r = it / 7, qb = r & 7, kvh = (r >> 3) & 1, b = r >> 4;
                        if ((kt == 4 && qb == 0) || (kt == 6 && qb == 7)) continue;
                        for (int rr = 0; rr <= REP(10); ++rr) attn_mfma_item(li, 32 + b, kvh, qb, kt, lds, tid, lane, wave); continue; } it -= 224;
                    if (it < 256) { for (int rr = 0; rr <= REP(8); ++rr) cscan_item<128, true>(li, it >> 3, (it >> 1) & 3, it & 1, lds, tid, lane, wave); continue; } it -= 256;
                    if (it < 256) { for (int rr = 0; rr <= REP(9); ++rr) cscan_item<64, false>(li, it >> 3, (it >> 1) & 3, it & 1, lds, tid, lane, wave); continue; } it -= 256;
                    if (it < 256) { for (int rr = 0; rr <= REP(10); ++rr) attn_mfma_item(li, it >> 3, (it >> 2) & 1, (it >> 1) & 1, it & 1, lds, tid, lane, wave); continue; } it -= 256;
                    if (EN(9)) hyena_mfma_item<0>(li, 0, it >> 2, it & 3, lds, tid, lane, wave);
                }
            } else if (k == 7) {
                for (int rr = 0; rr <= REP(12); ++rr)
                    for (int tok = gw; tok < TT; tok += NGW) finalize_token(li, tok, lane);
                for (;;) {
                    int it = dq_next(ctl + ph + 32 * rep, qslot, threadIdx.x);
                    if (it >= 320) break;
                    int tid = threadIdx.x, li = (ph - 1) / 12; asm volatile("" : "+v"(tid)); asm volatile("" : "+s"(li));
                    const int lane = tid & 63, wave = __builtin_amdgcn_readfirstlane(tid >> 6);
                    if (it < 64) { if (EN(10)) hyena_mfma_item<1>(li, 1, it, 0, lds, tid, lane, wave); continue; } it -= 64;
                    hyena_mfma_item<1>(li, 0, it >> 2, it & 3, lds, tid, lane, wave);
                }
            }
        }
        }
        if (ph + 1 < ph_hi) {
            if (ph == 0) cg::this_grid().sync();
            else xcd_barrier((unsigned*)(AWS() + WS_CTL) + CW_BAR, (volatile LAS unsigned*)((LAS unsigned char*)lds + 131072 + 128));
        }
    }

}

extern "C" void kernel_launch(void* const* d_in, const int* in_sizes, int n_in, void* d_out, int out_size, void* d_ws, size_t ws_size, hipStream_t stream) {
    static int grid = 0;
    if (grid == 0) {
        if (n_in != 35 || ws_size < WS_END) { fprintf(stderr, "kernel_launch: unexpected n_in %d / ws %zu\n", n_in, ws_size); grid = -1; return; }
        int dev = 0, cus = 0, per_cu = 0;
        hipGetDevice(&dev);
        hipDeviceGetAttribute(&cus, hipDeviceAttributeMultiprocessorCount, dev);
        if (hipFuncSetAttribute((const void*)mk_fwd, hipFuncAttributeMaxDynamicSharedMemorySize, LDS_BYTES) != hipSuccess) { fprintf(stderr, "kernel_launch: hipFuncSetAttribute failed\n"); grid = -1; return; }
        if (hipOccupancyMaxActiveBlocksPerMultiprocessor(&per_cu, (const void*)mk_fwd, NTHR, LDS_BYTES) != hipSuccess || per_cu < 1) { fprintf(stderr, "kernel_launch: occupancy query says %d\n", per_cu); per_cu = 1; }
        (void)hipGetLastError();
        if (per_cu > 1) per_cu = 1;
        grid = cus * per_cu;
    }
    if (grid < 0) return;
    hipMemsetAsync((char*)d_ws + WS_CTL, 0, CTL_ZERO_BYTES, stream);
    Args a{};
    for (int i = 0; i < 35; ++i) a.in[i] = (const float*)d_in[i];
    a.out = (float*)d_out; a.ws = (unsigned char*)d_ws;
#if MK_MULTI
    for (int ph = 0; ph < NPHASE; ++ph) { a.ph_lo = ph; a.ph_hi = ph + 1; hipLaunchKernelGGL(mk_fwd, dim3(grid), dim3(NTHR), LDS_BYTES, stream, a); }
#else
    a.ph_lo = 0; a.ph_hi = NPHASE + (MK_KEEP != 0x3F ? 1 : 0);
    void* args[] = {&a};
    hipError_t e = hipLaunchCooperativeKernel((const void*)mk_fwd, dim3(grid), dim3(NTHR), args, LDS_BYTES, stream);
    if (e != hipSuccess) fprintf(stderr, "cooperative launch failed: %s (grid %d)\n", hipGetErrorString(e), grid);
#endif
}
```
